# Optimizing an MI355X kernel written in HIP

```python
import jax
import jax.numpy as jnp
from jax import lax
import numpy as np

D_MODEL = 1024
BATCH = 2
SEQ = 8192
DEPTH = 1

CHUNK = 64
LEFT_CHUNKS = 8
N_HEADS = 8
HEAD_DIM = 64
ATTN_WIDTH = N_HEADS * HEAD_DIM
POOL_WINDOWS = (2, 4, 8, 16)
POOL_GROUPS = len(POOL_WINDOWS)
POOL_WIDTH = 512
POOL_GROUP_DIM = POOL_WIDTH // POOL_GROUPS
REL_CLIP = 128
D_FF = 2816
N_BRANCHES = 2
IN_COLS = 3 * ATTN_WIDTH + POOL_WIDTH + N_BRANCHES * D_MODEL
N_ADA = 9
EPS = 1e-6

kernel_name = 'hybrid_chunk_attn_pool_block'


def rms_norm(x, g):
    xf = x.astype(jnp.float32)
    y = xf * lax.rsqrt(jnp.mean(xf * xf, axis=-1, keepdims=True) + EPS)
    return (y * g.astype(jnp.float32)).astype(x.dtype)


def modulate(h, shift, scale):
    return h * (1 + scale) + shift


def swiglu(h, w_in, w_out):
    a, b = jnp.split(h @ w_in, 2, axis=-1)
    return (jax.nn.silu(a) * b) @ w_out


def chunk_band_attention(q, k, v, q_gain, k_gain, rel_bias):
    b, s, _ = q.shape
    nc = s // CHUNK
    band = (LEFT_CHUNKS + 1) * CHUNK
    q = rms_norm(q.reshape(b, nc, CHUNK, N_HEADS, HEAD_DIM), q_gain)
    k = rms_norm(k.reshape(b, nc, CHUNK, N_HEADS, HEAD_DIM), k_gain)
    v = v.reshape(b, nc, CHUNK, N_HEADS, HEAD_DIM)
    pad = ((0, 0), (LEFT_CHUNKS, 0), (0, 0), (0, 0), (0, 0))
    kp = jnp.pad(k, pad)
    vp = jnp.pad(v, pad)
    kb = jnp.concatenate([kp[:, w:w + nc] for w in range(LEFT_CHUNKS + 1)], axis=2)
    vb = jnp.concatenate([vp[:, w:w + nc] for w in range(LEFT_CHUNKS + 1)], axis=2)
    scores = jnp.einsum('bnqhd,bnkhd->bnhqk', q, kb).astype(jnp.float32) * (HEAD_DIM ** -0.5)
    r = np.arange(CHUNK)
    j = np.arange(band)
    dist = (LEFT_CHUNKS - j // CHUNK)[None, :] * CHUNK + r[:, None] - (j % CHUNK)[None, :]
    idx = np.clip(dist, -REL_CLIP, REL_CLIP) + REL_CLIP
    bias = rel_bias[:, idx].astype(jnp.float32)
    key_chunk = np.arange(nc)[:, None] - LEFT_CHUNKS + (j // CHUNK)[None, :]
    valid = jnp.asarray(key_chunk >= 0)[None, :, None, None, :]
    scores = jnp.where(valid, scores + bias[None, None], -1e30)
    p = jax.nn.softmax(scores, axis=-1).astype(v.dtype)
    out = jnp.einsum('bnhqk,bnkhd->bnqhd', p, vb)
    return out.reshape(b, s, ATTN_WIDTH)


def multiscale_pool(u, w_group, scale):
    b, s, _ = u.shape
    ug = u.reshape(b, s, POOL_GROUPS, POOL_GROUP_DIM).astype(jnp.float32)
    cs = jnp.pad(jnp.cumsum(ug, axis=1), ((0, 0), (1, 0), (0, 0), (0, 0)))
    t = np.arange(s)[:, None]
    win = np.array(POOL_WINDOWS)[None, :]
    start = np.maximum(t + 1 - win, 0)
    count = (t + 1 - start).astype(np.float32)
    lo = cs[:, start, np.arange(POOL_GROUPS)[None, :], :]
    mean = (cs[:, 1:] - lo) / count[None, :, :, None]
    mixed = (mean - ug).astype(u.dtype)
    y = jnp.einsum('bsgc,gcd->bsgd', mixed, w_group).reshape(b, s, POOL_WIDTH)
    return y * scale


def token_mix(h, w_in, q_gain, k_gain, rel_bias, w_attn_out, w_pool_group, pool_scale, w_pool_out, w_o):
    z = h @ w_in
    a3 = 3 * ATTN_WIDTH
    q, k, v, u, ga, gb = jnp.split(
        z, [ATTN_WIDTH, 2 * ATTN_WIDTH, a3, a3 + POOL_WIDTH, a3 + POOL_WIDTH + D_MODEL], axis=-1)
    ya = chunk_band_attention(q, k, v, q_gain, k_gain, rel_bias) @ w_attn_out
    yb = multiscale_pool(u, w_pool_group, pool_scale) @ w_pool_out
    merged = jax.nn.sigmoid(ga) * ya + jax.nn.sigmoid(gb) * yb
    return merged @ w_o


def setup_inputs(seed: int = 0) -> dict:
    key = jax.random.key(seed)
    ks = jax.random.split(key, 24)
    f32 = jnp.float32
    L = DEPTH

    def nrm(k, shape, scale):
        return jax.random.normal(k, shape, f32) * scale

    def gain(k, shape):
        return 1.0 + 0.05 * jax.random.normal(k, shape, f32)

    return {
        'x': nrm(ks[0], (BATCH, SEQ, D_MODEL), 1.0),
        'c': nrm(ks[1], (BATCH, D_MODEL), 1.0),
        'w_ada': nrm(ks[2], (L, D_MODEL, N_ADA * D_MODEL), D_MODEL ** -0.5),
        'b_ada': nrm(ks[3], (L, N_ADA * D_MODEL), 0.02),
        'g_ffn1': gain(ks[4], (L, D_MODEL)),
        'w_ffn1_in': nrm(ks[5], (L, D_MODEL, 2 * D_FF), D_MODEL ** -0.5),
        'w_ffn1_out': nrm(ks[6], (L, D_FF, D_MODEL), D_FF ** -0.5),
        'g_mix': gain(ks[7], (L, D_MODEL)),
        'w_in': nrm(ks[8], (L, D_MODEL, IN_COLS), D_MODEL ** -0.5),
        'q_gain': gain(ks[9], (L, HEAD_DIM)),
        'k_gain': gain(ks[10], (L, HEAD_DIM)),
        'rel_bias': nrm(ks[11], (L, N_HEADS, 2 * REL_CLIP + 1), 0.5),
        'w_attn_out': nrm(ks[12], (L, ATTN_WIDTH, D_MODEL), ATTN_WIDTH ** -0.5),
        'w_pool_group': nrm(ks[13], (L, POOL_GROUPS, POOL_GROUP_DIM, POOL_GROUP_DIM), POOL_GROUP_DIM ** -0.5),
        'pool_scale': gain(ks[14], (L, POOL_WIDTH)),
        'w_pool_out': nrm(ks[15], (L, POOL_WIDTH, D_MODEL), POOL_WIDTH ** -0.5),
        'w_o': nrm(ks[16], (L, D_MODEL, D_MODEL), D_MODEL ** -0.5),
        'g_ffn2': gain(ks[17], (L, D_MODEL)),
        'w_ffn2_in': nrm(ks[18], (L, D_MODEL, 2 * D_FF), D_MODEL ** -0.5),
        'w_ffn2_out': nrm(ks[19], (L, D_FF, D_MODEL), D_FF ** -0.5),
    }


def reference(x, c, w_ada, b_ada, g_ffn1, w_ffn1_in, w_ffn1_out, g_mix, w_in, q_gain, k_gain,
              rel_bias, w_attn_out, w_pool_group, pool_scale, w_pool_out, w_o, g_ffn2,
              w_ffn2_in, w_ffn2_out):
    b = x.shape[0]
    cc = jax.nn.silu(c)
    for l in range(DEPTH):
        mod = (cc @ w_ada[l] + b_ada[l]).reshape(b, N_ADA, D_MODEL)
        sh1, sc1, gt1, sh2, sc2, gt2, sh3, sc3, gt3 = [mod[:, i, None, :] for i in range(N_ADA)]
        h = modulate(rms_norm(x, g_ffn1[l]), sh1, sc1)
        x = x + 0.5 * gt1 * swiglu(h, w_ffn1_in[l], w_ffn1_out[l])
        h = modulate(rms_norm(x, g_mix[l]), sh2, sc2)
        x = x + gt2 * token_mix(h, w_in[l], q_gain[l], k_gain[l], rel_bias[l], w_attn_out[l],
                                w_pool_group[l], pool_scale[l], w_pool_out[l], w_o[l])
        h = modulate(rms_norm(x, g_ffn2[l]), sh3, sc3)
        x = x + 0.5 * gt3 * swiglu(h, w_ffn2_in[l], w_ffn2_out[l])
    return x
```

```cpp
#include <hip/hip_runtime.h>
#include <hip/hip_cooperative_groups.h>
#include <cstdio>
#include <cstdint>
namespace cg = cooperative_groups;
namespace pg8 {
#define PG8_LAS __attribute__((address_space(3)))
typedef unsigned short bf16_t;
typedef short bf16x8 __attribute__((ext_vector_type(8)));
typedef float f32x4 __attribute__((ext_vector_type(4)));
typedef unsigned u32x4 __attribute__((ext_vector_type(4)));
typedef unsigned u32x2 __attribute__((ext_vector_type(2)));
constexpr int BM = 256, BK = 64, HALF = 128, HTB = HALF * BK * 2  , STAGE_BYTES = 8 * HTB, NXCD = 8, WGM = 8;

__host__ __device__ __forceinline__ int lds_byte(int r, int c) { const int st = (r >> 4) * 2 + (c >> 5), rr = r & 15, cc = c & 31, ob = rr * 64 + cc * 2; return st * 1024 + (ob ^ (((ob >> 9) & 1) << 5)); }
__host__ __device__ __forceinline__ void stage_rc(int b, int& R, int& C) { const int st = b / 1024, sb = b % 1024, swz = sb ^ (((sb >> 9) & 1) << 5); R = (st >> 1) * 16 + swz / 64; C = (st & 1) * 32 + (swz % 64) / 2; }
__host__ __device__ __forceinline__ int perm32(int rho) { const int n = rho >> 4, i = rho & 15; return 8 * (i >> 2) + 4 * n + (i & 3); }

struct Unit { int pm, pn; };
struct Gemm { const bf16_t* A; const bf16_t* Bt; int M, N, K; };

struct StaticOrder {
    int nM, nN, nwg, G, c;
    __host__ __device__ void init(int M, int N, int G_, int c_) { nM = M / BM; nN = N / BM; nwg = nM * nN; G = G_; c = c_; }
    __host__ __device__ bool next(int i, Unit& u) const {
        const long L = (long)i * G + c; if (L >= nwg) return false;
        int wgid = (int)L; { const int q = nwg / NXCD, r = nwg % NXCD, xcd = wgid % NXCD, off = wgid / NXCD; wgid = (xcd < r ? xcd * (q + 1) : r * (q + 1) + (xcd - r) * q) + off; }
        const int nig = WGM * nN, gid = wgid / nig, fm = gid * WGM, gsz = (nM - fm) < WGM ? (nM - fm) : WGM;
        u.pm = fm + ((wgid % nig) % gsz); u.pn = (wgid % nig) / gsz; return true;
    }
    __device__ __forceinline__ void a_ready(const Unit&) const {}
    __device__ __forceinline__ void done(const Unit&) const {}
};

typedef float f32x2_cv __attribute__((ext_vector_type(2))); typedef __bf16 bf16x2_cv __attribute__((ext_vector_type(2)));
__device__ __forceinline__ unsigned cvt_pk_bf16(float lo, float hi) { f32x2_cv v = {lo, hi}; bf16x2_cv b = __builtin_convertvector(v, bf16x2_cv); return __builtin_bit_cast(unsigned, b); }
template <class Epi, class Sched, bool ALIGN_EPI = false, bool SP2 = false>
__device__ __forceinline__ void gemm_phase(PG8_LAS unsigned char* lds, const Gemm g, const Sched& S, const Epi& E) {
    const int tid = threadIdx.x, wid = __builtin_amdgcn_readfirstlane(tid >> 6), lane = tid & 63, wr = wid >> 2, wc = wid & 3, fr = lane & 15, fq = lane >> 4;
    const int K = g.K, nt = K / BK;
    unsigned voffA[2], voffB[2];
#pragma unroll
    for (int i = 0; i < 2; ++i) { int R, C; stage_rc(tid * 16 + i * 8192, R, C); const int Rb = Epi::PERM ? ((R & ~31) + perm32(R & 31)) : R;
        voffA[i] = (unsigned)(R * K + C) * 2u; voffB[i] = (unsigned)(Rb * K + C) * 2u; }
    const size_t kstep = (size_t)(BK * 2);
    const size_t hstep = (size_t)HALF * K * 2;
    const size_t tstep = 2 * hstep;
    const unsigned ldsw = (unsigned)wid * 1024u;
    const int aoff = lds_byte(wr * 64 + fr, fq * 8), boff = lds_byte(wc * 32 + fr, fq * 8);
#define PG8_SA(b, h) (((b) * 2 + (h)) * HTB)
#define PG8_SB(b, h) ((4 + (b) * 2 + (h)) * HTB)
#define PG8_STAGE(bufoff, gbase, voff) do { _Pragma("unroll") for (int _i = 0; _i < 2; ++_i) \
        __builtin_amdgcn_global_load_lds((const unsigned*)((const char*)(gbase) + (voff)[_i]), (PG8_LAS unsigned*)(lds + (bufoff) + ldsw + _i * 8192), 16, 0, 0); } while (0)
#define PG8_LDA(dst, b, h) do { _Pragma("unroll") for (int m = 0; m < 4; ++m) _Pragma("unroll") for (int k = 0; k < 2; ++k) dst[m][k] = *(const PG8_LAS bf16x8*)(lds + PG8_SA(b, h) + aoff + m * 2048 + k * 1024); } while (0)
#define PG8_LDB(dst, b, h) do { _Pragma("unroll") for (int n = 0; n < 2; ++n) _Pragma("unroll") for (int k = 0; k < 2; ++k) dst[n][k] = *(const PG8_LAS bf16x8*)(lds + PG8_SB(b, h) + boff + n * 2048 + k * 1024); } while (0)
#define PG8_MMA(ai, bj, At, Bt) do { __builtin_amdgcn_s_setprio(1); _Pragma("unroll") for (int m = 0; m < 4; ++m) _Pragma("unroll") for (int n = 0; n < 2; ++n) _Pragma("unroll") for (int k = 0; k < 2; ++k) \
        acc[ai][bj][m][n] = __builtin_amdgcn_mfma_f32_16x16x32_bf16(Bt[n][k], At[m][k], acc[ai][bj][m][n], 0, 0, 0); __builtin_amdgcn_s_setprio(0); } while (0)
#define PG8_WAIT_V(n) asm volatile("s_waitcnt vmcnt(" #n ")" ::: "memory")
#define PG8_WAIT_L(n) asm volatile("s_waitcnt lgkmcnt(" #n ")" ::: "memory")
#define PG8_BAR __builtin_amdgcn_s_barrier()
#define PG8_SCHED __builtin_amdgcn_sched_barrier(0)
    Unit cur, nxt; int ui = 0;
    if (!S.next(0, cur)) return;
    f32x4 acc[2][2][4][2];
#pragma unroll
    for (int a = 0; a < 2; ++a)
#pragma unroll
        for (int b = 0; b < 2; ++b)
#pragma unroll
            for (int m = 0; m < 4; ++m)
#pragma unroll
                for (int n = 0; n < 2; ++n) acc[a][b][m][n] = (f32x4){0.f, 0.f, 0.f, 0.f};
    bf16x8 At[4][2], B0[2][2], B1[2][2];
    const char* cA = (const char*)g.A + (size_t)cur.pm * tstep; const char* cB = (const char*)g.Bt + (size_t)cur.pn * tstep;
    S.a_ready(cur);
    if constexpr (SP2) {
        PG8_STAGE(PG8_SB(0, 0), cB, voffB); PG8_STAGE(PG8_SB(0, 1), cB + hstep, voffB); PG8_STAGE(PG8_SA(0, 0), cA, voffA); PG8_STAGE(PG8_SA(0, 1), cA + hstep, voffA);
        if (wr == 1) PG8_BAR;
        PG8_WAIT_V(2); PG8_BAR;
        PG8_STAGE(PG8_SB(1, 0), cB + kstep, voffB); PG8_STAGE(PG8_SA(1, 0), cA + kstep, voffA); PG8_STAGE(PG8_SB(1, 1), cB + hstep + kstep, voffB);
        PG8_WAIT_V(6); PG8_BAR;
    } else {
        PG8_STAGE(PG8_SB(0, 0), cB, voffB); PG8_STAGE(PG8_SA(0, 0), cA, voffA); PG8_STAGE(PG8_SB(0, 1), cB + hstep, voffB); PG8_STAGE(PG8_SA(0, 1), cA + hstep, voffA);
        if (wr == 1) PG8_BAR;
        PG8_WAIT_V(4); PG8_BAR;
        PG8_STAGE(PG8_SB(1, 0), cB + kstep, voffB); PG8_STAGE(PG8_SA(1, 0), cA + kstep, voffA); PG8_STAGE(PG8_SB(1, 1), cB + hstep + kstep, voffB);
        PG8_WAIT_V(6); PG8_BAR;
    }
    for (;;) {
        const bool has_next = S.next(ui + 1, nxt);
        const char* nA = has_next ? (const char*)g.A + (size_t)nxt.pm * tstep : cA; const char* nB = has_next ? (const char*)g.Bt + (size_t)nxt.pn * tstep : cB;
        for (int t = 0; t < nt; t += 2) {
            const bool last = (t == nt - 2);
            const char* a1 = cA + (size_t)(t + 1) * kstep;
            const char* a2 = last ? nA : cA + (size_t)(t + 2) * kstep; const char* b2 = last ? nB : cB + (size_t)(t + 2) * kstep;
            const char* a3 = a2 + kstep; const char* b3 = b2 + kstep;
            if (last && has_next) S.a_ready(nxt);
            if constexpr (SP2) {
            PG8_LDB(B0, 0, 0); PG8_LDB(B1, 0, 1); PG8_SCHED; PG8_LDA(At, 0, 0); PG8_STAGE(PG8_SA(1, 1), a1 + hstep, voffA);
            PG8_WAIT_V(8); PG8_WAIT_L(0); PG8_BAR; PG8_MMA(0, 0, At, B0); PG8_MMA(0, 1, At, B1); PG8_BAR; PG8_SCHED;
            PG8_LDA(At, 0, 1); PG8_STAGE(PG8_SB(0, 0), b2, voffB); PG8_STAGE(PG8_SB(0, 1), b2 + hstep, voffB); PG8_STAGE(PG8_SA(0, 0), a2, voffA);
            PG8_WAIT_V(8); PG8_WAIT_L(0); PG8_BAR; PG8_MMA(1, 0, At, B0); PG8_MMA(1, 1, At, B1); PG8_BAR; PG8_SCHED;
            PG8_LDB(B0, 1, 0); PG8_LDB(B1, 1, 1); PG8_SCHED; PG8_LDA(At, 1, 0); PG8_STAGE(PG8_SA(0, 1), a2 + hstep, voffA);
            PG8_WAIT_V(8); PG8_WAIT_L(0); PG8_BAR; PG8_MMA(0, 0, At, B0); PG8_MMA(0, 1, At, B1); PG8_BAR; PG8_SCHED;
            PG8_LDA(At, 1, 1); PG8_STAGE(PG8_SB(1, 0), b3, voffB); PG8_STAGE(PG8_SB(1, 1), b3 + hstep, voffB); PG8_STAGE(PG8_SA(1, 0), a3, voffA);
            PG8_WAIT_V(8); PG8_WAIT_L(0); PG8_BAR; PG8_MMA(1, 0, At, B0); PG8_MMA(1, 1, At, B1); PG8_BAR; PG8_SCHED;
            } else {
            PG8_LDB(B0, 0, 0); PG8_SCHED; PG8_LDA(At, 0, 0); PG8_STAGE(PG8_SA(1, 1), a1 + hstep, voffA);
            PG8_WAIT_L(8); PG8_BAR; PG8_WAIT_L(0); PG8_MMA(0, 0, At, B0); PG8_BAR; PG8_SCHED;
            PG8_LDB(B1, 0, 1); PG8_STAGE(PG8_SB(0, 0), b2, voffB);
            PG8_BAR; PG8_WAIT_L(0); PG8_MMA(0, 1, At, B1); PG8_BAR;
            PG8_LDA(At, 0, 1); PG8_STAGE(PG8_SA(0, 0), a2, voffA);
            PG8_BAR; PG8_WAIT_L(0); PG8_MMA(1, 0, At, B0); PG8_BAR; PG8_SCHED;
            PG8_STAGE(PG8_SB(0, 1), b2 + hstep, voffB);
            PG8_WAIT_V(6); PG8_BAR; PG8_MMA(1, 1, At, B1); PG8_BAR;
            PG8_LDB(B0, 1, 0); PG8_SCHED; PG8_LDA(At, 1, 0); PG8_STAGE(PG8_SA(0, 1), a2 + hstep, voffA);
            PG8_WAIT_L(8); PG8_BAR; PG8_WAIT_L(0); PG8_MMA(0, 0, At, B0); PG8_BAR; PG8_SCHED;
            PG8_LDB(B1, 1, 1); PG8_STAGE(PG8_SB(1, 0), b3, voffB);
            PG8_BAR; PG8_WAIT_L(0); PG8_MMA(0, 1, At, B1); PG8_BAR;
            PG8_LDA(At, 1, 1); PG8_STAGE(PG8_SA(1, 0), a3, voffA);
            PG8_BAR; PG8_WAIT_L(0); PG8_MMA(1, 0, At, B0); PG8_BAR; PG8_SCHED;
            PG8_STAGE(PG8_SB(1, 1), b3 + hstep, voffB);
            PG8_WAIT_V(6); PG8_BAR; PG8_MMA(1, 1, At, B1); PG8_BAR;
            }
        }
        if constexpr (ALIGN_EPI) { if (wr == 0) PG8_BAR; }
        if constexpr (!Epi::AFTER_DRAIN) { E(acc, cur, wr, wc, fr, fq); S.done(cur); }
        if (!has_next) break;
        if constexpr (!Epi::CHAIN) {
#pragma unroll
        for (int a = 0; a < 2; ++a)
#pragma unroll
            for (int b = 0; b < 2; ++b)
#pragma unroll
                for (int m = 0; m < 4; ++m)
#pragma unroll
                    for (int n = 0; n < 2; ++n) acc[a][b][m][n] = (f32x4){0.f, 0.f, 0.f, 0.f};
        }
        cur = nxt; cA = nA; cB = nB; ++ui;
        if constexpr (ALIGN_EPI) { if (wr == 1) PG8_BAR; }
    }
    PG8_WAIT_V(0);
    if constexpr (!ALIGN_EPI) { if (wr == 0) PG8_BAR; }
    PG8_BAR;
    if constexpr (Epi::AFTER_DRAIN) { E.fused(acc, cur, wr, wc, fr, fq, lds, wid, lane); S.done(cur); }
#undef PG8_SA
#undef PG8_SB
#undef PG8_STAGE
#undef PG8_LDA
#undef PG8_LDB
#undef PG8_MMA
#undef PG8_WAIT_V
#undef PG8_WAIT_L
#undef PG8_BAR
#undef PG8_SCHED
}
}

namespace pg8 {
__device__ __forceinline__ float sigm(float a) { return __builtin_amdgcn_rcpf(1.f + __builtin_amdgcn_exp2f(-1.4426950408889634f * a)); }
__device__ __forceinline__ float bf_lo(unsigned w) { return __builtin_bit_cast(float, w << 16); }
__device__ __forceinline__ float bf_hi(unsigned w) { return __builtin_bit_cast(float, w & 0xffff0000u); }
constexpr int SG_PITCH = 2048 + 64;

__device__ __forceinline__ float rstd_row(const float* rowp, int row) {
    const f32x4* p = (const f32x4*)(rowp + (size_t)row * 16); const f32x4 a = p[0], b = p[1], c = p[2], d = p[3];
    const float s = (((a[0] + a[1]) + (a[2] + a[3])) + ((b[0] + b[1]) + (b[2] + b[3]))) + (((c[0] + c[1]) + (c[2] + c[3])) + ((d[0] + d[1]) + (d[2] + d[3])));
    return 1.0f / sqrtf(s * (1.0f / 1024.0f) + 1e-6f);
}
template <bool NORM> struct EpiSwiGLU {
    static constexpr bool PERM = true, AFTER_DRAIN = false, CHAIN = false;
    bf16_t* O; int ldc; const PG8_LAS float* rsl; const PG8_LAS float* bl;
    __device__ __forceinline__ void operator()(const f32x4 (&acc)[2][2][4][2], const Unit& u, int wr, int wc, int fr, int fq) const {
        const int row0 = u.pm * BM + wr * 64 + fr, col0 = u.pn * HALF + wc * 32 + 8 * fq;
        f32x4 bv[2][2];
        if (NORM) {
#pragma unroll
            for (int bj = 0; bj < 2; ++bj)
#pragma unroll
                for (int n = 0; n < 2; ++n) bv[bj][n] = *(const PG8_LAS f32x4*)(bl + (u.pn >> 2) * BM + bj * HALF + wc * 32 + 8 * fq + 4 * n);
        }
#pragma unroll
        for (int ai = 0; ai < 2; ++ai)
#pragma unroll
            for (int m = 0; m < 4; ++m) {
                const int row = row0 + ai * HALF + m * 16;
                bf16_t* p = O + (size_t)row * ldc + col0;
                float rs = 1.f; if (NORM) rs = rsl[wr * 64 + fr + ai * HALF + m * 16];
                float v[8];
#pragma unroll
                for (int n = 0; n < 2; ++n)
#pragma unroll
                    for (int j = 0; j < 4; ++j) { float a = acc[ai][0][m][n][j], b = acc[ai][1][m][n][j];
                        if (NORM) { a = a * rs + bv[0][n][j]; b = b * rs + bv[1][n][j]; }
                        v[4 * n + j] = a * sigm(a) * b; }
                u32x4 w; w.x = cvt_pk_bf16(v[0], v[1]); w.y = cvt_pk_bf16(v[2], v[3]); w.z = cvt_pk_bf16(v[4], v[5]); w.w = cvt_pk_bf16(v[6], v[7]);
                *(u32x4*)p = w;
            }
    }
};

template <bool BASE_BF16, bool OUT_BF16> struct EpiRes2 {
    static constexpr bool PERM = true, AFTER_DRAIN = false, CHAIN = false;
    const void* base; void* out; const float* gate; float coef; float* rowp;
    __device__ __forceinline__ void operator()(const f32x4 (&acc)[2][2][4][2], const Unit& u, int wr, int wc, int fr, int fq) const {
        const float* g = gate + (u.pm >> 5) * 9216;
        const int row0 = u.pm * BM + wr * 64 + fr, col0 = u.pn * BM + wc * 32 + 8 * fq;
        f32x4 gv[2][2];
#pragma unroll
        for (int bj = 0; bj < 2; ++bj)
#pragma unroll
            for (int n = 0; n < 2; ++n) gv[bj][n] = *(const f32x4*)(g + col0 + bj * HALF + 4 * n) * coef;
#pragma unroll
        for (int ai = 0; ai < 2; ++ai)
#pragma unroll
            for (int m = 0; m < 4; ++m) {
                const int row = row0 + ai * HALF + m * 16; const size_t off = (size_t)row * 1024 + col0;
                f32x4 b0[2], b1[2];
#pragma unroll
                for (int bj = 0; bj < 2; ++bj) {
                    if (BASE_BF16) { const u32x4 t = *(const u32x4*)((const bf16_t*)base + off + bj * HALF);
                        b0[bj] = (f32x4){bf_lo(t.x), bf_hi(t.x), bf_lo(t.y), bf_hi(t.y)}; b1[bj] = (f32x4){bf_lo(t.z), bf_hi(t.z), bf_lo(t.w), bf_hi(t.w)}; }
                    else { b0[bj] = *(const f32x4*)((const float*)base + off + bj * HALF); b1[bj] = *(const f32x4*)((const float*)base + off + bj * HALF + 4); }
                }
                float ss = 0.f;
#pragma unroll
                for (int bj = 0; bj < 2; ++bj) {
                    const f32x4 v0 = b0[bj] + gv[bj][0] * acc[ai][bj][m][0], v1 = b1[bj] + gv[bj][1] * acc[ai][bj][m][1];
                    if (OUT_BF16) {
                        u32x4 w; w.x = cvt_pk_bf16(v0[0], v0[1]); w.y = cvt_pk_bf16(v0[2], v0[3]); w.z = cvt_pk_bf16(v1[0], v1[1]); w.w = cvt_pk_bf16(v1[2], v1[3]);
                        *(u32x4*)((bf16_t*)out + off + bj * HALF) = w;
                        ss += ((v0[0] * v0[0] + v0[1] * v0[1]) + (v0[2] * v0[2] + v0[3] * v0[3])) + ((v1[0] * v1[0] + v1[1] * v1[1]) + (v1[2] * v1[2] + v1[3] * v1[3]));
                    } else { *(f32x4*)((float*)out + off + bj * HALF) = v0; *(f32x4*)((float*)out + off + bj * HALF + 4) = v1; }
                }
                if (OUT_BF16) { ss += __shfl_xor(ss, 16); ss += __shfl_xor(ss, 32); if (fq == 0) rowp[(size_t)row * 16 + u.pn * 4 + wc] = ss; }
            }
    }
};

struct EpiWin {
    static constexpr bool PERM = true, AFTER_DRAIN = false, CHAIN = false;
    bf16_t *Q, *Kb, *V, *U, *SG; const PG8_LAS float* qkg; const PG8_LAS float* rsl; const PG8_LAS float* bl;
    __device__ __forceinline__ void operator()(const f32x4 (&acc)[2][2][4][2], const Unit& u, int wr, int wc, int fr, int fq) const {
        const int pn = u.pn, row0 = u.pm * BM + wr * 64 + fr;
        f32x4 bv[2][2];
#pragma unroll
        for (int bj = 0; bj < 2; ++bj)
#pragma unroll
            for (int n = 0; n < 2; ++n) bv[bj][n] = *(const PG8_LAS f32x4*)(bl + (pn >> 2) * BM + bj * HALF + wc * 32 + 8 * fq + 4 * n);
        f32x4 gv[2][2];
        if (pn < 4) { const PG8_LAS float* gain = qkg + (pn < 2 ? 0 : 64) + 8 * fq;
#pragma unroll
            for (int bj = 0; bj < 2; ++bj)
#pragma unroll
                for (int n = 0; n < 2; ++n) gv[bj][n] = *(const PG8_LAS f32x4*)(gain + 32 * bj + 4 * n); }
#pragma unroll
        for (int ai = 0; ai < 2; ++ai)
#pragma unroll
            for (int m = 0; m < 4; ++m) {
                const int row = row0 + ai * HALF + m * 16;
                const float rsn = rsl[wr * 64 + fr + ai * HALF + m * 16];
                f32x4 z[2][2];
#pragma unroll
                for (int bj = 0; bj < 2; ++bj)
#pragma unroll
                    for (int n = 0; n < 2; ++n) z[bj][n] = acc[ai][bj][m][n] * rsn + bv[bj][n];
                if (pn < 4) {
                    float ss = 0.f;
#pragma unroll
                    for (int bj = 0; bj < 2; ++bj)
#pragma unroll
                        for (int n = 0; n < 2; ++n) { const f32x4 x = z[bj][n]; ss += (x[0] * x[0] + x[1] * x[1]) + (x[2] * x[2] + x[3] * x[3]); }
                    ss += __shfl_xor(ss, 16); ss += __shfl_xor(ss, 32);
                    const float rs = 1.0f / sqrtf(ss * (1.0f / 64.0f) + 1e-6f);
                    bf16_t* p = (pn < 2 ? Q : Kb) + 256 * (pn & 1) + 64 * wc + 8 * fq + (size_t)row * 512;
#pragma unroll
                    for (int bj = 0; bj < 2; ++bj) { const f32x4 v0 = z[bj][0] * rs * gv[bj][0], v1 = z[bj][1] * rs * gv[bj][1];
                        u32x4 w; w.x = cvt_pk_bf16(v0[0], v0[1]); w.y = cvt_pk_bf16(v0[2], v0[3]); w.z = cvt_pk_bf16(v1[0], v1[1]); w.w = cvt_pk_bf16(v1[2], v1[3]);
                        *(u32x4*)(p + 32 * bj) = w; }
                } else if (pn < 8) {
                    bf16_t* p = (pn < 6 ? V : U) + 256 * (pn & 1) + 32 * wc + 8 * fq + (size_t)row * 512;
#pragma unroll
                    for (int bj = 0; bj < 2; ++bj) { const f32x4 v0 = z[bj][0], v1 = z[bj][1];
                        u32x4 w; w.x = cvt_pk_bf16(v0[0], v0[1]); w.y = cvt_pk_bf16(v0[2], v0[3]); w.z = cvt_pk_bf16(v1[0], v1[1]); w.w = cvt_pk_bf16(v1[2], v1[3]);
                        *(u32x4*)(p + bj * HALF) = w; }
                } else {
                    unsigned char* p = (unsigned char*)SG + 256 * (pn - 8) + 32 * wc + 8 * fq + (size_t)row * SG_PITCH;
#pragma unroll
                    for (int bj = 0; bj < 2; ++bj) { const f32x4 v0 = z[bj][0], v1 = z[bj][1];
                        u32x2 w;
                        w.x = (unsigned)(sigm(v0[0]) * 255.0f + 0.5f) | ((unsigned)(sigm(v0[1]) * 255.0f + 0.5f) << 8) | ((unsigned)(sigm(v0[2]) * 255.0f + 0.5f) << 16) | ((unsigned)(sigm(v0[3]) * 255.0f + 0.5f) << 24);
                        w.y = (unsigned)(sigm(v1[0]) * 255.0f + 0.5f) | ((unsigned)(sigm(v1[1]) * 255.0f + 0.5f) << 8) | ((unsigned)(sigm(v1[2]) * 255.0f + 0.5f) << 16) | ((unsigned)(sigm(v1[3]) * 255.0f + 0.5f) << 24);
                        *(u32x2*)(p + bj * HALF) = w; }
                }
            }
    }
};

template <bool ACCUM> struct EpiGate {
    static constexpr bool PERM = true, AFTER_DRAIN = false, CHAIN = false;
    bf16_t* T; const bf16_t* SG; int goff;
    __device__ __forceinline__ void operator()(const f32x4 (&acc)[2][2][4][2], const Unit& u, int wr, int wc, int fr, int fq) const {
        const int row0 = u.pm * BM + wr * 64 + fr, col0 = u.pn * BM + wc * 32 + 8 * fq;
#pragma unroll
        for (int ai = 0; ai < 2; ++ai)
#pragma unroll
            for (int m = 0; m < 4; ++m) { const size_t row = (size_t)(row0 + ai * HALF + m * 16);
#pragma unroll
                for (int bj = 0; bj < 2; ++bj) {
                    const u32x2 g = *(const u32x2*)((const unsigned char*)SG + row * SG_PITCH + goff + col0 + bj * HALF);
                    const f32x4 a0 = acc[ai][bj][m][0], a1 = acc[ai][bj][m][1];
                    const float q = 1.0f / 255.0f;
                    float v[8] = { (float)(g.x & 255u) * q * a0[0], (float)((g.x >> 8) & 255u) * q * a0[1], (float)((g.x >> 16) & 255u) * q * a0[2], (float)(g.x >> 24) * q * a0[3], (float)(g.y & 255u) * q * a1[0], (float)((g.y >> 8) & 255u) * q * a1[1], (float)((g.y >> 16) & 255u) * q * a1[2], (float)(g.y >> 24) * q * a1[3] };
                    bf16_t* p = T + row * 1024 + col0 + bj * HALF;
                    if (ACCUM) { const u32x4 t = *(const u32x4*)p;
                        v[0] += bf_lo(t.x); v[1] += bf_hi(t.x); v[2] += bf_lo(t.y); v[3] += bf_hi(t.y); v[4] += bf_lo(t.z); v[5] += bf_hi(t.z); v[6] += bf_lo(t.w); v[7] += bf_hi(t.w); }
                    u32x4 w; w.x = cvt_pk_bf16(v[0], v[1]); w.y = cvt_pk_bf16(v[2], v[3]); w.z = cvt_pk_bf16(v[4], v[5]); w.w = cvt_pk_bf16(v[6], v[7]);
                    *(u32x4*)p = w; } }
    }
};
struct ChainOrder {
    StaticOrder so;
    __device__ bool next(int i, Unit& u) const { if (i > 1 || !so.next(0, u)) return false; if (i == 1) { u.pm += 64; u.pn += 4; } return true; }
    __device__ __forceinline__ void a_ready(const Unit&) const {}
    __device__ __forceinline__ void done(const Unit&) const {}
};
struct EpiChain {
    static constexpr bool PERM = true, AFTER_DRAIN = false, CHAIN = true;
    bf16_t* T; const unsigned char* SG;
    __device__ __forceinline__ void operator()(f32x4 (&acc)[2][2][4][2], const Unit& u, int wr, int wc, int fr, int fq) const {
        const bool second = u.pm >= 64; const int pm = second ? u.pm - 64 : u.pm, pn = second ? u.pn - 4 : u.pn;
        const int row0 = pm * BM + wr * 64 + fr, col0 = pn * BM + wc * 32 + 8 * fq;
#pragma unroll
        for (int ai = 0; ai < 2; ++ai)
#pragma unroll
            for (int m = 0; m < 4; ++m) { const size_t row = (size_t)(row0 + ai * HALF + m * 16);
#pragma unroll
                for (int bj = 0; bj < 2; ++bj) {
                    const u32x2 gb = *(const u32x2*)(SG + row * SG_PITCH + 1024 + col0 + bj * HALF);
                    float fb[8] = { (float)(gb.x & 255u), (float)((gb.x >> 8) & 255u), (float)((gb.x >> 16) & 255u), (float)(gb.x >> 24), (float)(gb.y & 255u), (float)((gb.y >> 8) & 255u), (float)((gb.y >> 16) & 255u), (float)(gb.y >> 24) };
#pragma unroll
                    for (int j = 0; j < 8; ++j) fb[j] = fmaxf(fb[j], 1.0f);
                    if (!second) {
                        const u32x2 ga = *(const u32x2*)(SG + row * SG_PITCH + col0 + bj * HALF);
                        const float fa[8] = { (float)(ga.x & 255u), (float)((ga.x >> 8) & 255u), (float)((ga.x >> 16) & 255u), (float)(ga.x >> 24), (float)(ga.y & 255u), (float)((ga.y >> 8) & 255u), (float)((ga.y >> 16) & 255u), (float)(ga.y >> 24) };
#pragma unroll
                        for (int j = 0; j < 4; ++j) { acc[ai][bj][m][0][j] *= fa[j] * __builtin_amdgcn_rcpf(fb[j]); acc[ai][bj][m][1][j] *= fa[4 + j] * __builtin_amdgcn_rcpf(fb[4 + j]); }
                    } else {
                        const float q = 1.0f / 255.0f; const f32x4 a0 = acc[ai][bj][m][0], a1 = acc[ai][bj][m][1];
                        u32x4 w; w.x = cvt_pk_bf16(fb[0] * q * a0[0], fb[1] * q * a0[1]); w.y = cvt_pk_bf16(fb[2] * q * a0[2], fb[3] * q * a0[3]);
                        w.z = cvt_pk_bf16(fb[4] * q * a1[0], fb[5] * q * a1[1]); w.w = cvt_pk_bf16(fb[6] * q * a1[2], fb[7] * q * a1[3]);
                        *(u32x4*)(T + row * 1024 + col0 + bj * HALF) = w;
                    }
                } }
    }
};
}

#define GAS __attribute__((address_space(1)))
#define LAS __attribute__((address_space(3)))
typedef unsigned short bf16;
typedef unsigned v4u __attribute__((ext_vector_type(4)));
typedef unsigned v2u __attribute__((ext_vector_type(2)));
typedef float f32x4 __attribute__((ext_vector_type(4)));
typedef float f32x16 __attribute__((ext_vector_type(16)));
typedef short bf16x8 __attribute__((ext_vector_type(8)));
typedef short __attribute__((may_alias)) short_a;
typedef short v4i16_t __attribute__((ext_vector_type(4)));
typedef v4u __attribute__((may_alias)) v4u_a;

#ifndef MK_PER_PHASE
#define MK_PER_PHASE 0
#endif
constexpr int NPHASE = 10;
constexpr int BATCH = 2, SEQ = 8192, DM = 1024, M = BATCH * SEQ, DFF = 2816, NFF = 2 * DFF, NIN = 4096, AW = 512, NADA = 9 * DM, NCHUNK = SEQ / 64;
constexpr int NBIAS = NIN + NFF;
constexpr size_t MiB = 1u << 20;
constexpr size_t WS_MOD = 1 * MiB;
constexpr size_t WS_W1 = 2 * MiB, WS_W2 = 13 * MiB, WS_WIN = 19 * MiB  , WS_WA = 35 * MiB, WS_WC = 36 * MiB, WS_WO = 37 * MiB, WS_W3 = 39 * MiB  , WS_W4 = 61 * MiB;
static_assert(WS_WC == WS_WA + (size_t)DM * AW * 2, "Wa and Wc stacked");
constexpr size_t WS_XN = 67 * MiB;
constexpr size_t WS_ACT = 99 * MiB;
constexpr size_t WS_Q = 99 * MiB, WS_K = 115 * MiB, WS_V = 131 * MiB, WS_U = 147 * MiB, WS_SG = 163 * MiB;
constexpr size_t WS_XB2 = 99 * MiB;
constexpr size_t WS_ACT2 = 131 * MiB;
constexpr size_t WS_ROWP2 = 230 * MiB, WS_ROWP3 = 231 * MiB;
constexpr size_t WS_BIASP = 232 * MiB;
constexpr size_t WS_BIAS = 234 * MiB;
constexpr size_t WS_END = 235 * MiB;
static_assert(WS_SG + (size_t)M * pg8::SG_PITCH <= WS_ROWP2, "gate buffer fits below the row-sum tables");
constexpr int LDS_BYTES = 147456;

__device__ __forceinline__ unsigned f2bf(float f) { unsigned u = __builtin_bit_cast(unsigned, f); return (u + 0x7fffu + ((u >> 16) & 1u)) >> 16; }
__device__ __forceinline__ unsigned pk2(float lo, float hi) { return f2bf(lo) | (f2bf(hi) << 16); }
__device__ __forceinline__ float wave_sum(float v) {
#pragma unroll
    for (int o = 1; o < 64; o <<= 1) v += __shfl_xor(v, o);
    return v;
}
__device__ __forceinline__ float silu_f(float a) { return a / (1.f + __expf(-a)); }

__device__ __forceinline__ int dst_row0(int mode, int n0) {
    if (mode == 1) { const int hb = n0 >= DFF ? 1 : 0, j = n0 - hb * DFF; return 256 * (j >> 7) + 128 * hb + (j & 127); }
    if (mode == 2 && n0 < 1024) { const int pn = n0 >> 8, c = n0 & 255, hh = c >> 6, e = c & 63; return 256 * pn + 128 * (e >> 5) + 32 * hh + (e & 31); }
    return n0;
}
template <bool SCALED> __device__ __forceinline__ void transpose_item_t(const float* W, int K, int N, bf16* WT, int mode, LAS float* scr, int item, int lane, const float* gvec, const float* scv, const float* shv, float* biasp) {
    const int nblk = N / 32, kb = item / nblk, nb = item % nblk, k0 = 64 * kb, n0 = 32 * nb, d0 = dst_row0(mode, n0);
    float tv[32];
#pragma unroll
    for (int i = 0; i < 32; ++i) tv[i] = W[(size_t)(k0 + 2 * i + (lane >> 5)) * N + n0 + (lane & 31)];
    if (SCALED) {
        float part = 0.f;
#pragma unroll
        for (int i = 0; i < 32; ++i) { const int k = k0 + 2 * i + (lane >> 5); part += tv[i] * shv[k]; tv[i] *= gvec[k] * (1.0f + scv[k]); }
        part += __shfl_xor(part, 32);
        if (lane < 32) biasp[(size_t)kb * NBIAS + d0 + lane] = part;
    }
#pragma unroll
    for (int i = 0; i < 32; ++i) scr[(2 * i + (lane >> 5)) * 33 + (lane & 31)] = tv[i];
    asm volatile("s_waitcnt lgkmcnt(0)" ::: "memory");
    const int c = lane & 7;
#pragma unroll
    for (int j = 0; j < 4; ++j) { const int n = (lane >> 3) + 8 * j; const LAS float* s = scr + (8 * c) * 33 + n;
        v4u o; o.x = pk2(s[0 * 33], s[1 * 33]); o.y = pk2(s[2 * 33], s[3 * 33]); o.z = pk2(s[4 * 33], s[5 * 33]); o.w = pk2(s[6 * 33], s[7 * 33]);
        *(v4u*)(WT + (size_t)(d0 + n) * K + k0 + 8 * c) = o; }
    asm volatile("s_waitcnt lgkmcnt(0)" ::: "memory");
}
__device__ __forceinline__ void transpose_item(const float* W, int K, int N, bf16* WT, int mode, LAS float* scr, int item, int lane) { transpose_item_t<false>(W, K, N, WT, mode, scr, item, lane, nullptr, nullptr, nullptr, nullptr); }

__device__ __forceinline__ void norm_row(const float* xrow, bf16* orow, const float* g, const float* sh, const float* sc, int lane) {
    const f32x4* xr = (const f32x4*)xrow + lane;
    f32x4 v[4]; float s = 0.f;
#pragma unroll
    for (int j = 0; j < 4; ++j) { v[j] = xr[64 * j]; s += (v[j].x * v[j].x + v[j].y * v[j].y) + (v[j].z * v[j].z + v[j].w * v[j].w); }
    const float rs = 1.0f / sqrtf(wave_sum(s) * (1.f / DM) + 1e-6f);
    unsigned long long* o8 = (unsigned long long*)orow + lane;
#pragma unroll
    for (int j = 0; j < 4; ++j) {
        const f32x4 gg = ((const f32x4*)g)[64 * j + lane], s1 = ((const f32x4*)sc)[64 * j + lane], s0 = ((const f32x4*)sh)[64 * j + lane];
        const f32x4 h = v[j] * rs * gg * (s1 + 1.0f) + s0;
        o8[64 * j] = (unsigned long long)pk2(h.x, h.y) | ((unsigned long long)pk2(h.z, h.w) << 32);
    }
}

__device__ __forceinline__ void attn_wave(LAS unsigned char* wl, const bf16* Q, const bf16* K, const bf16* V, bf16* O, const float* relb, int b, int n, int h, int lane) {
    const int r32 = lane & 31, hf = lane >> 5;
    const int trb = (4 * hf + ((lane & 15) >> 2)) * 192 + (16 * ((lane >> 4) & 1) + 4 * (lane & 3)) * 2;
    LAS float* biasL = (LAS float*)(wl + 6144);
    for (int i = lane; i < 257; i += 64) biasL[i] = relb[h * 257 + i] * 1.4426950408889634f;
    const size_t tq0 = (size_t)b * SEQ + (size_t)n * 64;
    bf16x8 qf[2][4];
#pragma unroll
    for (int qb = 0; qb < 2; ++qb)
#pragma unroll
        for (int ks = 0; ks < 4; ++ks) qf[qb][ks] = *(const bf16x8*)(Q + (tq0 + 32 * qb + r32) * AW + h * 64 + 16 * ks + 8 * hf);
    f32x16 o[2][2];
#pragma unroll
    for (int db = 0; db < 2; ++db)
#pragma unroll
        for (int qb = 0; qb < 2; ++qb)
#pragma unroll
            for (int i = 0; i < 16; ++i) o[db][qb][i] = 0.f;
    float mrun[2] = {-INFINITY, -INFINITY}, lrun[2] = {0.f, 0.f};
    const float CL2 = 0.125f * 1.4426950408889634f;
    const int kk0 = n >= 8 ? 0 : 2 * (8 - n);
    const bf16* kp = K + ((size_t)b * SEQ + (size_t)(n - 8) * 64 + r32) * AW + h * 64 + 8 * hf;
    const bf16* vp = V + ((size_t)b * SEQ + (size_t)(n - 8) * 64 + (lane >> 3)) * AW + h * 64 + 8 * (lane & 7);
    bf16x8 kf[4]; v4u vr[4];
#pragma unroll
    for (int ks = 0; ks < 4; ++ks) kf[ks] = *(const bf16x8*)(kp + (size_t)kk0 * 32 * AW + 16 * ks);
#pragma unroll
    for (int i = 0; i < 4; ++i) vr[i] = *(const v4u*)(vp + ((size_t)kk0 * 32 + 8 * i) * AW);
    for (int kk = kk0; kk < 18; ++kk) {
        f32x16 s[2];
#pragma unroll
        for (int qb = 0; qb < 2; ++qb) {
#pragma unroll
            for (int i = 0; i < 16; ++i) s[qb][i] = 0.f;
#pragma unroll
            for (int ks = 0; ks < 4; ++ks) s[qb] = __builtin_amdgcn_mfma_f32_32x32x16_bf16(kf[ks], qf[qb][ks], s[qb], 0, 0, 0);
        }
#pragma unroll
        for (int i = 0; i < 4; ++i) *(LAS v4u_a*)(wl + ((lane >> 3) + 8 * i) * 192 + 16 * (lane & 7)) = vr[i];
        if (kk + 1 < 18) {
#pragma unroll
            for (int ks = 0; ks < 4; ++ks) kf[ks] = *(const bf16x8*)(kp + (size_t)(kk + 1) * 32 * AW + 16 * ks);
#pragma unroll
            for (int i = 0; i < 4; ++i) vr[i] = *(const v4u*)(vp + ((size_t)(kk + 1) * 32 + 8 * i) * AW);
        }
        const int dbase = 512 - 32 * kk - 4 * hf + r32;
        float mx[2];
        if (kk < 12) {
            const float cb = biasL[256];
#pragma unroll
            for (int qb = 0; qb < 2; ++qb) { float m_ = -INFINITY;
#pragma unroll
                for (int i = 0; i < 16; ++i) { const float val = s[qb][i] * CL2 + cb; s[qb][i] = val; m_ = fmaxf(m_, val); }
                mx[qb] = m_; }
        } else {
#pragma unroll
            for (int qb = 0; qb < 2; ++qb) { float m_ = -INFINITY;
#pragma unroll
                for (int i = 0; i < 16; ++i) {
                    int dist = dbase + 32 * qb - (8 * (i >> 2) + (i & 3)); dist = dist > 128 ? 128 : dist;
                    const float val = s[qb][i] * CL2 + biasL[dist + 128];
                    s[qb][i] = val; m_ = fmaxf(m_, val);
                }
                mx[qb] = m_; }
        }
        mx[0] = fmaxf(mx[0], __shfl_xor(mx[0], 32)); mx[1] = fmaxf(mx[1], __shfl_xor(mx[1], 32));
        if (__any((mx[0] > mrun[0] + 8.0f) || (mx[1] > mrun[1] + 8.0f))) {
#pragma unroll
            for (int qb = 0; qb < 2; ++qb) {
                const float mnew = fmaxf(mrun[qb], mx[qb]), alpha = __builtin_amdgcn_exp2f(mrun[qb] - mnew);
                mrun[qb] = mnew; lrun[qb] *= alpha;
#pragma unroll
                for (int db = 0; db < 2; ++db)
#pragma unroll
                    for (int i = 0; i < 16; ++i) o[db][qb][i] *= alpha;
            }
        }
#pragma unroll
        for (int qb = 0; qb < 2; ++qb) {
            float sum = 0.f;
#pragma unroll
            for (int i = 0; i < 16; ++i) { const float p = __builtin_amdgcn_exp2f(s[qb][i] - mrun[qb]); s[qb][i] = p; sum += p; }
            sum += __shfl_xor(sum, 32);
            lrun[qb] += sum;
        }
#pragma unroll
        for (int j2 = 0; j2 < 2; ++j2) {
            bf16x8 pf[2];
#pragma unroll
            for (int qb = 0; qb < 2; ++qb) {
                const unsigned p0 = pg8::cvt_pk_bf16(s[qb][8 * j2 + 0], s[qb][8 * j2 + 1]), p1 = pg8::cvt_pk_bf16(s[qb][8 * j2 + 2], s[qb][8 * j2 + 3]);
                const unsigned p2 = pg8::cvt_pk_bf16(s[qb][8 * j2 + 4], s[qb][8 * j2 + 5]), p3 = pg8::cvt_pk_bf16(s[qb][8 * j2 + 6], s[qb][8 * j2 + 7]);
                pf[qb] = __builtin_bit_cast(bf16x8, (v4u){p0, p1, p2, p3});
            }
#pragma unroll
            for (int db = 0; db < 2; ++db) {
                const v4i16_t lo = __builtin_amdgcn_ds_read_tr16_b64_v4i16((LAS v4i16_t*)(wl + trb + (16 * j2) * 192 + 64 * db));
                const v4i16_t hi = __builtin_amdgcn_ds_read_tr16_b64_v4i16((LAS v4i16_t*)(wl + trb + (16 * j2 + 8) * 192 + 64 * db));
                const bf16x8 vf = {lo[0], lo[1], lo[2], lo[3], hi[0], hi[1], hi[2], hi[3]};
#pragma unroll
                for (int qb = 0; qb < 2; ++qb) o[db][qb] = __builtin_amdgcn_mfma_f32_32x32x16_bf16(vf, pf[qb], o[db][qb], 0, 0, 0);
            }
        }
    }
#pragma unroll
    for (int qb = 0; qb < 2; ++qb) {
        const float inv = 1.0f / lrun[qb];
        bf16* orow = O + (tq0 + 32 * qb + r32) * AW + h * 64 + 4 * hf;
#pragma unroll
        for (int db = 0; db < 2; ++db)
#pragma unroll
            for (int g = 0; g < 4; ++g) {
                v2u w; w.x = pg8::cvt_pk_bf16(o[db][qb][4 * g + 0] * inv, o[db][qb][4 * g + 1] * inv); w.y = pg8::cvt_pk_bf16(o[db][qb][4 * g + 2] * inv, o[db][qb][4 * g + 3] * inv);
                *(v2u*)(orow + 32 * db + 8 * g) = w;
            }
    }
}

template <int WIN> __device__ __forceinline__ void pool_wave(const bf16* UB, bf16* MIX, int b, int n, int g, int th, int lane) {
    constexpr int R = 7 + WIN;
    const int o = lane & 15, tb = lane >> 4;
    const int s0 = n * 64 + th * 32 + tb * 8;
    const bf16* ub = UB + (size_t)b * SEQ * AW + g * 128 + 8 * o;
    v4u rows[R];
#pragma unroll
    for (int j = 0; j < R; ++j) { const int pos = s0 - (WIN - 1) + j; const v4u t = *(const v4u*)(ub + (size_t)(pos < 0 ? 0 : pos) * AW);
        rows[j] = pos < 0 ? (v4u){0u, 0u, 0u, 0u} : t; }
    float acc[8];
#pragma unroll
    for (int e = 0; e < 8; ++e) acc[e] = 0.f;
#define POOL_UNPACK(f, t, msk) const float f[8] = { pg8::bf_lo(t.x) * msk, pg8::bf_hi(t.x) * msk, pg8::bf_lo(t.y) * msk, pg8::bf_hi(t.y) * msk, pg8::bf_lo(t.z) * msk, pg8::bf_hi(t.z) * msk, pg8::bf_lo(t.w) * msk, pg8::bf_hi(t.w) * msk }
#pragma unroll
    for (int j = 0; j < WIN; ++j) { POOL_UNPACK(f, rows[j], 1.f);
#pragma unroll
        for (int e = 0; e < 8; ++e) acc[e] += f[e]; }
#pragma unroll
    for (int tt = 0; tt < 8; ++tt) {
        const int s = s0 + tt, cnt = (s + 1) < WIN ? (s + 1) : WIN;
        const float inv = __builtin_amdgcn_rcpf((float)cnt);
        POOL_UNPACK(self, rows[tt + WIN - 1], 1.f);
        v4u ov; ov.x = pg8::cvt_pk_bf16(acc[0] * inv - self[0], acc[1] * inv - self[1]); ov.y = pg8::cvt_pk_bf16(acc[2] * inv - self[2], acc[3] * inv - self[3]);
        ov.z = pg8::cvt_pk_bf16(acc[4] * inv - self[4], acc[5] * inv - self[5]); ov.w = pg8::cvt_pk_bf16(acc[6] * inv - self[6], acc[7] * inv - self[7]);
        *(v4u*)(MIX + ((size_t)b * SEQ + s) * AW + g * 128 + 8 * o) = ov;
        if (tt < 7) { POOL_UNPACK(fin, rows[tt + WIN], 1.f); POOL_UNPACK(fout, rows[tt], 1.f);
#pragma unroll
            for (int e = 0; e < 8; ++e) acc[e] += fin[e] - fout[e]; }
    }
#undef POOL_UNPACK
}

#define XB_TMO      128
#define XB_XCNT(j)  (256  + 64 * (j))
#define XB_XSUB(j)  (1280 + 64 * (j))
#define XB_XGEN(j)  (2304 + 64 * (j))
#define XB_TOP      3328
#define XB_TOPGEN   3392
#define XCD_BAR_WORDS 3456
#define XB_SPIN_CAP (1u << 18)

__device__ __forceinline__ unsigned xb_ld(unsigned* p)              { return __hip_atomic_load(p, __ATOMIC_RELAXED, __HIP_MEMORY_SCOPE_AGENT); }
__device__ __forceinline__ unsigned xb_add(unsigned* p, unsigned v) { return __hip_atomic_fetch_add(p, v, __ATOMIC_RELAXED, __HIP_MEMORY_SCOPE_AGENT); }
__device__ __forceinline__ unsigned xb_xcc_id() { return (unsigned)__builtin_amdgcn_s_getreg((3 << 11) | 20) & 0xFu; }
#define XB_SPIN(cond, bar) do { unsigned _sp = 0; while (cond) { __builtin_amdgcn_s_sleep(1); \
    if ((++_sp & 255u) == 0u) { if (xb_ld(&(bar)[XB_TMO])) break; if (_sp > XB_SPIN_CAP) { atomicAdd(&(bar)[XB_TMO], 1u); break; } } } } while (0)

struct XcdBarrier {
    unsigned* bar; unsigned x;
    volatile LAS unsigned* st;
};

__device__ __forceinline__ XcdBarrier xcd_barrier_post(unsigned* bar, volatile LAS unsigned* st) {
    XcdBarrier b; b.bar = bar; b.x = xb_xcc_id(); b.st = st;
    if (threadIdx.x == 0) (void)xb_add(&bar[XB_XCNT(b.x)], 1u);
    return b;
}
__device__ __forceinline__ void xcd_barrier_complete(unsigned* bar, unsigned x, unsigned& nloc, unsigned& nx) {
    const unsigned G = gridDim.x * gridDim.y * gridDim.z;
    unsigned sum, cnt, mine, sp = 0u;
    for (;;) {
        sum = 0u; cnt = 0u; mine = 0u;
#pragma unroll
        for (unsigned j = 0; j < 16; ++j) { const unsigned c = xb_ld(&bar[XB_XCNT(j)]); sum += c; cnt += (c > 0u) ? 1u : 0u; mine = (j == x) ? c : mine; }
        if (sum == G) break;
        __builtin_amdgcn_s_sleep(1);
        if ((++sp & 255u) == 0u) { if (xb_ld(&bar[XB_TMO])) break; if (sp > XB_SPIN_CAP) { atomicAdd(&bar[XB_TMO], 1u); break; } }
    }
    nloc = mine > 0u ? mine : 1u; nx = cnt > 0u ? cnt : 1u;
}

__device__ __forceinline__ void xcd_barrier(const XcdBarrier& b) {
    asm volatile("s_waitcnt vmcnt(0)" ::: "memory");
    __syncthreads();
    if (threadIdx.x == 0) {
        unsigned* bar = b.bar;
        __builtin_amdgcn_s_waitcnt(0);
        unsigned nloc = b.st[0], nx = b.st[1];
        if (nloc == 0u) { xcd_barrier_complete(bar, b.x, nloc, nx); b.st[0] = nloc; b.st[1] = nx; }
        const unsigned old = xb_add(&bar[XB_XSUB(b.x)], 1u);
        const unsigned gen = old / nloc;
        if (old + 1u == (gen + 1u) * nloc) {
            __builtin_amdgcn_fence(__ATOMIC_RELEASE, "agent");
            asm volatile("s_waitcnt vmcnt(0)" ::: "memory");
            const unsigned og = xb_add(&bar[XB_TOP], 1u);
            const unsigned tg = og / nx;
            if (og + 1u == (tg + 1u) * nx) xb_add(&bar[XB_TOPGEN], 1u);
            else XB_SPIN(xb_ld(&bar[XB_TOPGEN]) == tg, bar);
            __builtin_amdgcn_fence(__ATOMIC_ACQUIRE, "agent");
            xb_add(&bar[XB_XGEN(b.x)], 1u);
            asm volatile("s_waitcnt vmcnt(0)" ::: "memory");
        } else {
            XB_SPIN(xb_ld(&bar[XB_XGEN(b.x)]) == gen, bar);
            __builtin_amdgcn_fence(__ATOMIC_ACQUIRE, "agent");
            asm volatile("s_waitcnt vmcnt(0)" ::: "memory");
        }
    }
    __syncthreads();
}

__device__ __forceinline__ void group_barrier(unsigned* cnt, unsigned target) {
    asm volatile("s_waitcnt vmcnt(0)" ::: "memory");
    __syncthreads();
    if (threadIdx.x == 0) {
        (void)xb_add(cnt, 1u);
        unsigned sp = 0u;
        while (xb_ld(cnt) < target) { __builtin_amdgcn_s_sleep(1); if (++sp > (1u << 22)) break; }
        __builtin_amdgcn_fence(__ATOMIC_ACQUIRE, "agent");
        asm volatile("s_waitcnt vmcnt(0)" ::: "memory");
    }
    __syncthreads();
}

struct Args { const float* in[20]; float* out; unsigned char* ws; int ph_lo, ph_hi; };

__global__ void __launch_bounds__(512, 2) hybrid_fwd(Args args) {
    extern __shared__ __attribute__((aligned(16))) unsigned char lds_[];
    LAS unsigned char* lds = (LAS unsigned char*)lds_;
    int tid = threadIdx.x, lane = tid & 63; const int wave = __builtin_amdgcn_readfirstlane(tid >> 6);
    const int G = gridDim.x, blk = blockIdx.x;
    const int gw = blk * 8 + wave, NGW = G * 8;
    cg::grid_group grid = cg::this_grid();
    unsigned char* ws = args.ws;
    const float* x = args.in[0]; const float* cvec = args.in[1]; const float* w_ada = args.in[2]; const float* b_ada = args.in[3];
    const float* g_ffn1 = args.in[4]; const float* w_ffn1_in = args.in[5]; const float* w_ffn1_out = args.in[6]; const float* g_mix = args.in[7];
    const float* w_in = args.in[8]; const float* q_gain = args.in[9]; const float* k_gain = args.in[10]; const float* rel_bias = args.in[11];
    const float* w_attn_out = args.in[12]; const float* w_pool_group = args.in[13]; const float* pool_scale = args.in[14]; const float* w_pool_out = args.in[15];
    const float* w_o = args.in[16]; const float* g_ffn2 = args.in[17]; const float* w_ffn2_in = args.in[18]; const float* w_ffn2_out = args.in[19];
    float* out = args.out;
    float* mod = (float*)(ws + WS_MOD);
    bf16 *W1 = (bf16*)(ws + WS_W1), *W2 = (bf16*)(ws + WS_W2), *WIN = (bf16*)(ws + WS_WIN), *WA = (bf16*)(ws + WS_WA), *WC = (bf16*)(ws + WS_WC), *WO = (bf16*)(ws + WS_WO), *W3 = (bf16*)(ws + WS_W3), *W4 = (bf16*)(ws + WS_W4);
    bf16 *XN = (bf16*)(ws + WS_XN), *ACT = (bf16*)(ws + WS_ACT), *ACT2 = (bf16*)(ws + WS_ACT2), *QB = (bf16*)(ws + WS_Q), *KB = (bf16*)(ws + WS_K), *VB = (bf16*)(ws + WS_V), *UB = (bf16*)(ws + WS_U), *SG = (bf16*)(ws + WS_SG), *XB2 = (bf16*)(ws + WS_XB2);
    bf16 *XB1 = (bf16*)out, *ATT = (bf16*)out + (size_t)M * DM, *MIX = (bf16*)out + (size_t)M * DM + (size_t)M * AW;
    float *ROWP2 = (float*)(ws + WS_ROWP2), *ROWP3 = (float*)(ws + WS_ROWP3), *BIASP = (float*)(ws + WS_BIASP), *BIAS = (float*)(ws + WS_BIAS);
    bf16* TM = XN;
    const int lo = args.ph_lo, hi = args.ph_hi;
    for (int u = tid; u < (LDS_BYTES - 131072) / 4; u += 512) ((LAS unsigned*)(lds + 131072))[u] = 0u;
    __syncthreads();
    XcdBarrier bar = xcd_barrier_post((unsigned*)ws + 4096, (volatile LAS unsigned*)(lds + 131072 + 352));
    unsigned* const xcctab = (unsigned*)ws + 12288;
    unsigned* const gcnt = (unsigned*)ws + 8192 + 64 * (blk & 63);
    if (tid == 0) __hip_atomic_store(xcctab + blk, xb_xcc_id() + 1u, __ATOMIC_RELAXED, __HIP_MEMORY_SCOPE_AGENT);
    bool grp_local = false; unsigned gepoch = 0u;
    if (lo < 0) grid.sync();
#define IN(k) (lo <= (k) && (k) < hi)
#define OPQ(v) asm volatile("" : "+v"(v))
#define SEAM(k) do { if (IN(k) && IN((k) + 1)) xcd_barrier(bar); } while (0)
#define SEAM_G(k) do { if (IN(k) && IN((k) + 1)) { if (grp_local) { gepoch += 4u; group_barrier(gcnt, gepoch); } else xcd_barrier(bar); } } while (0)

    if (IN(0)) {
        OPQ(lane);
        LAS float* scr = (LAS float*)(lds + wave * 16384);
        constexpr int I_1 = (DM / 64) * (NFF / 32);
        constexpr int I_4 = (DFF / 64) * (DM / 32), I_A0 = (AW / 64) * (DM / 32), I_O0 = (DM / 64) * (DM / 32);
        for (int it = gw; it < I_1 + 2 * I_4 + I_A0 + I_O0; it += NGW) {
            int r = it;
            if (r < I_1) { transpose_item(w_ffn1_in, DM, NFF, W1, 1, scr, r, lane); continue; } r -= I_1;
            if (r < I_4) { transpose_item(w_ffn1_out, DFF, DM, W2, 0, scr, r, lane); continue; } r -= I_4;
            if (r < I_4) { transpose_item(w_ffn2_out, DFF, DM, W4, 0, scr, r, lane); continue; } r -= I_4;
            if (r < I_A0) { transpose_item(w_attn_out, AW, DM, WA, 0, scr, r, lane); continue; } r -= I_A0;
            transpose_item(w_o, DM, DM, WO, 0, scr, r, lane);
        }
        for (int task = gw; task < 2048; task += NGW) {
            const int iq = task >> 4, nb = task & 15, n = nb * 64 + lane, g = iq >> 5, c0 = (iq & 31) * 4;
            const float* wg = w_pool_group + ((size_t)g * 128 + c0) * 128;
#pragma unroll
            for (int e = 0; e < 4; ++e) { scr[lane * 4 + e] = wg[e * 128 + lane] * pool_scale[g * 128 + lane]; scr[(lane + 64) * 4 + e] = wg[e * 128 + 64 + lane] * pool_scale[g * 128 + 64 + lane]; }
            asm volatile("s_waitcnt lgkmcnt(0)" ::: "memory");
            float acc[4] = {0.f, 0.f, 0.f, 0.f};
            const float* wp = w_pool_out + (size_t)g * 128 * DM + n;
#pragma unroll 16
            for (int d = 0; d < 128; ++d) {
                const float p = wp[(size_t)d * DM];
                const f32x4 a = *(const LAS f32x4*)(scr + d * 4);
                acc[0] += a[0] * p; acc[1] += a[1] * p; acc[2] += a[2] * p; acc[3] += a[3] * p;
            }
            v2u o; o.x = pk2(acc[0], acc[1]); o.y = pk2(acc[2], acc[3]);
            *(v2u*)(WC + (size_t)n * AW + g * 128 + c0) = o;
            asm volatile("s_waitcnt lgkmcnt(0)" ::: "memory");
        }
        LAS float* red = (LAS float*)(lds + 12288);
        for (int cb = blk; cb < 256; cb += G) {
            const int c4 = lane & 15, ks = lane >> 4;
            f32x4 a0 = {0.f, 0.f, 0.f, 0.f}, a1 = {0.f, 0.f, 0.f, 0.f};
            if (c4 < 9) {
                const int j = 36 * cb + 4 * c4, kbase = wave * 128 + ks * 32;
#pragma unroll 8
                for (int i = 0; i < 32; ++i) { const int k = kbase + i; const f32x4 wv = *(const f32x4*)(w_ada + (size_t)k * NADA + j);
                    a0 += wv * silu_f(cvec[k]); a1 += wv * silu_f(cvec[DM + k]); }
            }
#pragma unroll
            for (int e = 0; e < 4; ++e) { a0[e] += __shfl_xor(a0[e], 16); a0[e] += __shfl_xor(a0[e], 32); a1[e] += __shfl_xor(a1[e], 16); a1[e] += __shfl_xor(a1[e], 32); }
            __syncthreads();
            if (lane < 9) {
#pragma unroll
                for (int e = 0; e < 4; ++e) { red[(wave * 2 + 0) * 36 + 4 * lane + e] = a0[e]; red[(wave * 2 + 1) * 36 + 4 * lane + e] = a1[e]; }
            }
            __syncthreads();
            if (tid < 72) { const int bb = tid / 36, jj = tid % 36; float s = b_ada[36 * cb + jj];
#pragma unroll
                for (int wv = 0; wv < 8; ++wv) s += red[(wv * 2 + bb) * 36 + jj];
                mod[bb * NADA + 36 * cb + jj] = s; }
        }
        __syncthreads();
    }
    SEAM(0);
    if (IN(0) && IN(1) && G == 256) {
        LAS unsigned* gl = (LAS unsigned*)(lds + 131072 + 512);
        if (tid < 64) { const unsigned a = __hip_atomic_load(xcctab + tid, __ATOMIC_RELAXED, __HIP_MEMORY_SCOPE_AGENT), b2 = __hip_atomic_load(xcctab + tid + 64, __ATOMIC_RELAXED, __HIP_MEMORY_SCOPE_AGENT),
                                           c2 = __hip_atomic_load(xcctab + tid + 128, __ATOMIC_RELAXED, __HIP_MEMORY_SCOPE_AGENT), d2 = __hip_atomic_load(xcctab + tid + 192, __ATOMIC_RELAXED, __HIP_MEMORY_SCOPE_AGENT);
            const bool okg = (a != 0u) && a == b2 && a == c2 && a == d2;
            const unsigned long long m = __ballot(okg);
            if (tid == 0) gl[0] = (m == ~0ull) ? 1u : 0u; }
        __syncthreads();
        grp_local = gl[0] != 0u;
    }
    if (IN(1)) { OPQ(lane);
        for (int m = gw; m < M; m += NGW) { const float* mb = mod + (m >> 13) * NADA; norm_row(x + (size_t)m * DM, XN + (size_t)m * DM, g_ffn1, mb + 0 * DM, mb + 1 * DM, lane); }
        LAS float* scr = (LAS float*)(lds + wave * 16384);
        constexpr int I_1 = (DM / 64) * (NFF / 32);
        for (int it = gw; it < 2 * I_1; it += NGW) { const int bb = it >= I_1 ? 1 : 0; const float* mb = mod + bb * NADA;
            transpose_item_t<true>(w_ffn2_in, DM, NFF, W3 + (size_t)bb * NFF * DM, 1, scr, it - bb * I_1, lane, g_ffn2, mb + 7 * DM, mb + 6 * DM, BIASP + (size_t)bb * 16 * NBIAS + NIN); }
    }
    SEAM(1);
    if (IN(2)) { pg8::Gemm g{XN, W1, M, NFF, DM}; pg8::StaticOrder S; S.init(M, NFF, G, blk); pg8::EpiSwiGLU<false> E{ACT, DFF, nullptr, nullptr};
        pg8::gemm_phase<pg8::EpiSwiGLU<false>, pg8::StaticOrder, true, true>(lds, g, S, E);
        const int hb = (G == 256) ? 128 : 0;
        if (blk >= hb) {
            OPQ(lane);
            LAS float* scr = (LAS float*)(lds + wave * 16384);
            constexpr int I_IN = (DM / 64) * (NIN / 32);
            for (int it = (blk - hb) * 8 + wave; it < 2 * I_IN; it += (G - hb) * 8) { const int bb = it >= I_IN ? 1 : 0; const float* mb = mod + bb * NADA;
                transpose_item_t<true>(w_in, DM, NIN, WIN + (size_t)bb * NIN * DM, 2, scr, it - bb * I_IN, lane, g_mix, mb + 4 * DM, mb + 3 * DM, BIASP + (size_t)bb * 16 * NBIAS); }
        }
    }
    SEAM(2);
    if (IN(3)) {
        for (int idx = blk * 512 + tid; idx < 2 * NBIAS; idx += G * 512) { const int bb = idx / NBIAS, col = idx - bb * NBIAS; float sacc = 0.f;
#pragma unroll
            for (int kb = 0; kb < 16; ++kb) sacc += BIASP[((size_t)bb * 16 + kb) * NBIAS + col];
            BIAS[idx] = sacc; }
        pg8::Gemm g{ACT, W2, M, DM, DFF}; pg8::StaticOrder S; S.init(M, DM, G, blk); pg8::EpiRes2<false, true> E{x, XB1, mod + 2 * DM, 0.5f, ROWP2};
        pg8::gemm_phase<pg8::EpiRes2<false, true>, pg8::StaticOrder, true, true>(lds, g, S, E); }
    SEAM(3);
    if (IN(4)) { pg8::StaticOrder S; S.init(M, NIN, G, blk); pg8::Unit u0; u0.pm = 0; u0.pn = 0; S.next(0, u0); const int bb = u0.pm >> 5;
        LAS float* rsl = (LAS float*)(lds + 131072 + 1024);
        LAS float* bl = (LAS float*)(lds + 131072 + 2048); LAS float* qkg = (LAS float*)(lds + 131072 + 8192);
        if (tid < 256) { rsl[tid] = pg8::rstd_row(ROWP2, u0.pm * 256 + tid); pg8::Unit uu; for (int i = 0; S.next(i, uu); ++i) bl[i * 256 + tid] = BIAS[(size_t)bb * NBIAS + uu.pn * 256 + tid]; }
        else if (tid < 384) qkg[tid - 256] = tid < 320 ? q_gain[tid - 256] : k_gain[tid - 320];
        __syncthreads();
        pg8::Gemm g{XB1, WIN + (size_t)bb * NIN * DM, M, NIN, DM}; pg8::EpiWin E{QB, KB, VB, UB, SG, qkg, rsl, bl};
        pg8::gemm_phase<pg8::EpiWin, pg8::StaticOrder, true, true>(lds, g, S, E); }
    SEAM(4);
    if (IN(5)) {
        OPQ(lane); OPQ(tid);
        for (int u0 = blk; u0 < BATCH * NCHUNK; u0 += G) {
            const int unit = (u0 & 7) * (BATCH * NCHUNK / 8) + (u0 >> 3);
            const int b = unit / NCHUNK, n = unit % NCHUNK;
            attn_wave(lds + wave * 8192, QB, KB, VB, ATT, rel_bias, b, n, wave, lane);
            { const int g = wave >> 1, th = wave & 1;
              if (g == 0) pool_wave<2>(UB, MIX, b, n, 0, th, lane); else if (g == 1) pool_wave<4>(UB, MIX, b, n, 1, th, lane);
              else if (g == 2) pool_wave<8>(UB, MIX, b, n, 2, th, lane); else pool_wave<16>(UB, MIX, b, n, 3, th, lane); }
        }
        __syncthreads();
    }
    SEAM(5);
    if (IN(6)) {
        pg8::Gemm g{ATT, WA, 2 * M, 2 * DM, AW}; pg8::ChainOrder S; S.so.init(M, DM, G, blk); pg8::EpiChain E{TM, (const unsigned char*)SG};
        pg8::gemm_phase<pg8::EpiChain, pg8::ChainOrder, true, true>(lds, g, S, E);
    }
    SEAM_G(6);
    if (IN(7)) { pg8::Gemm g{TM, WO, M, DM, DM}; pg8::StaticOrder S; S.init(M, DM, G, blk); pg8::EpiRes2<true, true> E{XB1, XB2, mod + 5 * DM, 1.0f, ROWP3};
        pg8::gemm_phase<pg8::EpiRes2<true, true>, pg8::StaticOrder, true, true>(lds, g, S, E); }
    SEAM(7);
    if (IN(8)) { pg8::StaticOrder S; S.init(M, NFF, G, blk); pg8::Unit u0; u0.pm = 0; u0.pn = 0; S.next(0, u0); const int bb = u0.pm >> 5;
        LAS float* rsl = (LAS float*)(lds + 131072 + 1024);
        LAS float* bl = (LAS float*)(lds + 131072 + 2048);
        if (tid < 256) { rsl[tid] = pg8::rstd_row(ROWP3, u0.pm * 256 + tid); pg8::Unit uu; for (int i = 0; S.next(i, uu); ++i) bl[i * 256 + tid] = BIAS[(size_t)bb * NBIAS + NIN + uu.pn * 256 + tid]; }
        __syncthreads();
        pg8::Gemm g{XB2, W3 + (size_t)bb * NFF * DM, M, NFF, DM}; pg8::EpiSwiGLU<true> E{ACT2, DFF, rsl, bl};
        pg8::gemm_phase<pg8::EpiSwiGLU<true>, pg8::StaticOrder, true, true>(lds, g, S, E); }
    SEAM_G(8);
    if (IN(9)) { pg8::Gemm g{ACT2, W4, M, DM, DFF}; pg8::StaticOrder S; S.init(M, DM, G, blk); pg8::EpiRes2<true, false> E{XB2, out, mod + 8 * DM, 0.5f, nullptr};
        pg8::gemm_phase<pg8::EpiRes2<true, false>, pg8::StaticOrder, true, true>(lds, g, S, E); }
#undef IN
#undef SEAM
}

extern "C" void kernel_launch(void* const* d_in, const int* in_sizes, int n_in, void* d_out, int out_size, void* d_ws, size_t ws_size, hipStream_t stream) {
    static int grid = 0;
    if (grid == 0) {
        if (n_in != 20 || in_sizes[0] != M * DM || out_size != M * DM || ws_size < WS_END) { fprintf(stderr, "kernel_launch: unexpected shapes (n_in %d, in0 %d, out %d, ws %zu); nothing launched\n", n_in, n_in > 0 ? in_sizes[0] : -1, out_size, ws_size); grid = -1; return; }
        int dev = 0, cus = 0, per_cu = 0;
        if (hipGetDevice(&dev) != hipSuccess || hipDeviceGetAttribute(&cus, hipDeviceAttributeMultiprocessorCount, dev) != hipSuccess) { fprintf(stderr, "kernel_launch: device query failed\n"); grid = -1; return; }
        if (hipFuncSetAttribute((const void*)hybrid_fwd, hipFuncAttributeMaxDynamicSharedMemorySize, LDS_BYTES) != hipSuccess) { fprintf(stderr, "kernel_launch: hipFuncSetAttribute failed\n"); grid = -1; return; }
        if (hipOccupancyMaxActiveBlocksPerMultiprocessor(&per_cu, (const void*)hybrid_fwd, 512, LDS_BYTES) != hipSuccess || per_cu < 1) { fprintf(stderr, "kernel_launch: occupancy query says %d\n", per_cu); per_cu = 1; }
        (void)hipGetLastError();
        grid = cus * per_cu;
        if (grid > 256) grid = 256;
        if (grid != 256) { fprintf(stderr, "kernel_launch: this kernel needs exactly 256 co-resident workgroups (got %d); nothing launched\n", grid); grid = -1; return; }
    }
    if (grid < 0) return;
    if (hipMemsetAsync(d_ws, 0, 65536, stream) != hipSuccess) { fprintf(stderr, "kernel_launch: hipMemsetAsync failed\n"); return; }
    Args a{};
    for (int i = 0; i < 20; ++i) a.in[i] = (const float*)d_in[i];
    a.out = (float*)d_out; a.ws = (unsigned char*)d_ws;
#if MK_PER_PHASE
    for (int k = 0; k < NPHASE; ++k) { a.ph_lo = k; a.ph_hi = k + 1; hipLaunchKernelGGL(hybrid_fwd, dim3(grid), dim3(512), LDS_BYTES, stream, a); }
#else
    a.ph_lo = 0; a.ph_hi = NPHASE;
    void* kargs[] = {&a};
    const hipError_t e = hipLaunchCooperativeKernel((const void*)hybrid_fwd, dim3(grid), dim3(512), kargs, LDS_BYTES, stream);
    if (e != hipSuccess) fprintf(stderr, "kernel_launch: cooperative launch failed: %s (grid %d)\n", hipGetErrorString(e), grid);
#endif
}
```

```cpp
#include <hip/hip_runtime.h>
#include <hip/hip_cooperative_groups.h>
#include <cstdio>
#include <cstdint>
namespace cg = cooperative_groups;
namespace pg8 {
#define PG8_LAS __attribute__((address_space(3)))
typedef unsigned short bf16_t;
typedef short bf16x8 __attribute__((ext_vector_type(8)));
typedef float f32x4 __attribute__((ext_vector_type(4)));
typedef unsigned u32x4 __attribute__((ext_vector_type(4)));
typedef unsigned u32x2 __attribute__((ext_vector_type(2)));
constexpr int BM = 256, BK = 64, HALF = 128, HTB = HALF * BK * 2  , STAGE_BYTES = 8 * HTB, NXCD = 8, WGM = 8;

__host__ __device__ __forceinline__ int lds_byte(int r, int c) { const int st = (r >> 4) * 2 + (c >> 5), rr = r & 15, cc = c & 31, ob = rr * 64 + cc * 2; return st * 1024 + (ob ^ (((ob >> 9) & 1) << 5)); }
__host__ __device__ __forceinline__ void stage_rc(int b, int& R, int& C) { const int st = b / 1024, sb = b % 1024, swz = sb ^ (((sb >> 9) & 1) << 5); R = (st >> 1) * 16 + swz / 64; C = (st & 1) * 32 + (swz % 64) / 2; }
__host__ __device__ __forceinline__ int perm32(int rho) { const int n = rho >> 4, i = rho & 15; return 8 * (i >> 2) + 4 * n + (i & 3); }

struct Unit { int pm, pn; };
struct Gemm { const bf16_t* A; const bf16_t* Bt; int M, N, K; };

struct StaticOrder {
    int nM, nN, nwg, G, c;
    __host__ __device__ void init(int M, int N, int G_, int c_) { nM = M / BM; nN = N / BM; nwg = nM * nN; G = G_; c = c_; }
    __host__ __device__ bool next(int i, Unit& u) const {
        const long L = (long)i * G + c; if (L >= nwg) return false;
        int wgid = (int)L; { const int q = nwg / NXCD, r = nwg % NXCD, xcd = wgid % NXCD, off = wgid / NXCD; wgid = (xcd < r ? xcd * (q + 1) : r * (q + 1) + (xcd - r) * q) + off; }
        const int nig = WGM * nN, gid = wgid / nig, fm = gid * WGM, gsz = (nM - fm) < WGM ? (nM - fm) : WGM;
        u.pm = fm + ((wgid % nig) % gsz); u.pn = (wgid % nig) / gsz; return true;
    }
    __device__ __forceinline__ void a_ready(const Unit&) const {}
    __device__ __forceinline__ void done(const Unit&) const {}
};

typedef float f32x2_cv __attribute__((ext_vector_type(2))); typedef __bf16 bf16x2_cv __attribute__((ext_vector_type(2)));
__device__ __forceinline__ unsigned cvt_pk_bf16(float lo, float hi) { f32x2_cv v = {lo, hi}; bf16x2_cv b = __builtin_convertvector(v, bf16x2_cv); return __builtin_bit_cast(unsigned, b); }
template <class Epi, class Sched, bool ALIGN_EPI = false, bool SP2 = false>
__device__ __forceinline__ void gemm_phase(PG8_LAS unsigned char* lds, const Gemm g, const Sched& S, const Epi& E) {
    const int tid = threadIdx.x, wid = __builtin_amdgcn_readfirstlane(tid >> 6), lane = tid & 63, wr = wid >> 2, wc = wid & 3, fr = lane & 15, fq = lane >> 4;
    const int K = g.K, nt = K / BK;
    unsigned voffA[2], voffB[2];
#pragma unroll
    for (int i = 0; i < 2; ++i) { int R, C; stage_rc(tid * 16 + i * 8192, R, C); const int Rb = Epi::PERM ? ((R & ~31) + perm32(R & 31)) : R;
        voffA[i] = (unsigned)(R * K + C) * 2u; voffB[i] = (unsigned)(Rb * K + C) * 2u; }
    const size_t kstep = (size_t)(BK * 2);
    const size_t hstep = (size_t)HALF * K * 2;
    const size_t tstep = 2 * hstep;
    const unsigned ldsw = (unsigned)wid * 1024u;
    const int aoff = lds_byte(wr * 64 + fr, fq * 8), boff = lds_byte(wc * 32 + fr, fq * 8);
#define PG8_SA(b, h) (((b) * 2 + (h)) * HTB)
#define PG8_SB(b, h) ((4 + (b) * 2 + (h)) * HTB)
#define PG8_STAGE(bufoff, gbase, voff) do { _Pragma("unroll") for (int _i = 0; _i < 2; ++_i) \
        __builtin_amdgcn_global_load_lds((const unsigned*)((const char*)(gbase) + (voff)[_i]), (PG8_LAS unsigned*)(lds + (bufoff) + ldsw + _i * 8192), 16, 0, 0); } while (0)
#define PG8_LDA(dst, b, h) do { _Pragma("unroll") for (int m = 0; m < 4; ++m) _Pragma("unroll") for (int k = 0; k < 2; ++k) dst[m][k] = *(const PG8_LAS bf16x8*)(lds + PG8_SA(b, h) + aoff + m * 2048 + k * 1024); } while (0)
#define PG8_LDB(dst, b, h) do { _Pragma("unroll") for (int n = 0; n < 2; ++n) _Pragma("unroll") for (int k = 0; k < 2; ++k) dst[n][k] = *(const PG8_LAS bf16x8*)(lds + PG8_SB(b, h) + boff + n * 2048 + k * 1024); } while (0)
#define PG8_MMA(ai, bj, At, Bt) do { __builtin_amdgcn_s_setprio(1); _Pragma("unroll") for (int m = 0; m < 4; ++m) _Pragma("unroll") for (int n = 0; n < 2; ++n) _Pragma("unroll") for (int k = 0; k < 2; ++k) \
        acc[ai][bj][m][n] = __builtin_amdgcn_mfma_f32_16x16x32_bf16(Bt[n][k], At[m][k], acc[ai][bj][m][n], 0, 0, 0); __builtin_amdgcn_s_setprio(0); } while (0)
#define PG8_WAIT_V(n) asm volatile("s_waitcnt vmcnt(" #n ")" ::: "memory")
#define PG8_WAIT_L(n) asm volatile("s_waitcnt lgkmcnt(" #n ")" ::: "memory")
#define PG8_BAR __builtin_amdgcn_s_barrier()
#define PG8_SCHED __builtin_amdgcn_sched_barrier(0)
    Unit cur, nxt; int ui = 0;
    if (!S.next(0, cur)) return;
    f32x4 acc[2][2][4][2];
#pragma unroll
    for (int a = 0; a < 2; ++a)
#pragma unroll
        for (int b = 0; b < 2; ++b)
#pragma unroll
            for (int m = 0; m < 4; ++m)
#pragma unroll
                for (int n = 0; n < 2; ++n) acc[a][b][m][n] = (f32x4){0.f, 0.f, 0.f, 0.f};
    bf16x8 At[4][2], B0[2][2], B1[2][2];
    const char* cA = (const char*)g.A + (size_t)cur.pm * tstep; const char* cB = (const char*)g.Bt + (size_t)cur.pn * tstep;
    S.a_ready(cur);
    if constexpr (SP2) {
        PG8_STAGE(PG8_SB(0, 0), cB, voffB); PG8_STAGE(PG8_SB(0, 1), cB + hstep, voffB); PG8_STAGE(PG8_SA(0, 0), cA, voffA); PG8_STAGE(PG8_SA(0, 1), cA + hstep, voffA);
        if (wr == 1) PG8_BAR;
        PG8_WAIT_V(2); PG8_BAR;
        PG8_STAGE(PG8_SB(1, 0), cB + kstep, voffB); PG8_STAGE(PG8_SA(1, 0), cA + kstep, voffA); PG8_STAGE(PG8_SB(1, 1), cB + hstep + kstep, voffB);
        PG8_WAIT_V(6); PG8_BAR;
    } else {
        PG8_STAGE(PG8_SB(0, 0), cB, voffB); PG8_STAGE(PG8_SA(0, 0), cA, voffA); PG8_STAGE(PG8_SB(0, 1), cB + hstep, voffB); PG8_STAGE(PG8_SA(0, 1), cA + hstep, voffA);
        if (wr == 1) PG8_BAR;
        PG8_WAIT_V(4); PG8_BAR;
        PG8_STAGE(PG8_SB(1, 0), cB + kstep, voffB); PG8_STAGE(PG8_SA(1, 0), cA + kstep, voffA); PG8_STAGE(PG8_SB(1, 1), cB + hstep + kstep, voffB);
        PG8_WAIT_V(6); PG8_BAR;
    }
    for (;;) {
        const bool has_next = S.next(ui + 1, nxt);
        const char* nA = has_next ? (const char*)g.A + (size_t)nxt.pm * tstep : cA; const char* nB = has_next ? (const char*)g.Bt + (size_t)nxt.pn * tstep : cB;
        for (int t = 0; t < nt; t += 2) {
            const bool last = (t == nt - 2);
            const char* a1 = cA + (size_t)(t + 1) * kstep;
            const char* a2 = last ? nA : cA + (size_t)(t + 2) * kstep; const char* b2 = last ? nB : cB + (size_t)(t + 2) * kstep;
            const char* a3 = a2 + kstep; const char* b3 = b2 + kstep;
            if (last && has_next) S.a_ready(nxt);
            if constexpr (SP2) {
            PG8_LDB(B0, 0, 0); PG8_LDB(B1, 0, 1); PG8_SCHED; PG8_LDA(At, 0, 0); PG8_STAGE(PG8_SA(1, 1), a1 + hstep, voffA);
            PG8_WAIT_V(8); PG8_WAIT_L(0); PG8_BAR; PG8_MMA(0, 0, At, B0); PG8_MMA(0, 1, At, B1); PG8_BAR; PG8_SCHED;
            PG8_LDA(At, 0, 1); PG8_STAGE(PG8_SB(0, 0), b2, voffB); PG8_STAGE(PG8_SB(0, 1), b2 + hstep, voffB); PG8_STAGE(PG8_SA(0, 0), a2, voffA);
            PG8_WAIT_V(8); PG8_WAIT_L(0); PG8_BAR; PG8_MMA(1, 0, At, B0); PG8_MMA(1, 1, At, B1); PG8_BAR; PG8_SCHED;
            PG8_LDB(B0, 1, 0); PG8_LDB(B1, 1, 1); PG8_SCHED; PG8_LDA(At, 1, 0); PG8_STAGE(PG8_SA(0, 1), a2 + hstep, voffA);
            PG8_WAIT_V(8); PG8_WAIT_L(0); PG8_BAR; PG8_MMA(0, 0, At, B0); PG8_MMA(0, 1, At, B1); PG8_BAR; PG8_SCHED;
            PG8_LDA(At, 1, 1); PG8_STAGE(PG8_SB(1, 0), b3, voffB); PG8_STAGE(PG8_SB(1, 1), b3 + hstep, voffB); PG8_STAGE(PG8_SA(1, 0), a3, voffA);
            PG8_WAIT_V(8); PG8_WAIT_L(0); PG8_BAR; PG8_MMA(1, 0, At, B0); PG8_MMA(1, 1, At, B1); PG8_BAR; PG8_SCHED;
            } else {
            PG8_LDB(B0, 0, 0); PG8_SCHED; PG8_LDA(At, 0, 0); PG8_STAGE(PG8_SA(1, 1), a1 + hstep, voffA);
            PG8_WAIT_L(8); PG8_BAR; PG8_WAIT_L(0); PG8_MMA(0, 0, At, B0); PG8_BAR; PG8_SCHED;
            PG8_LDB(B1, 0, 1); PG8_STAGE(PG8_SB(0, 0), b2, voffB);
            PG8_BAR; PG8_WAIT_L(0); PG8_MMA(0, 1, At, B1); PG8_BAR;
            PG8_LDA(At, 0, 1); PG8_STAGE(PG8_SA(0, 0), a2, voffA);
            PG8_BAR; PG8_WAIT_L(0); PG8_MMA(1, 0, At, B0); PG8_BAR; PG8_SCHED;
            PG8_STAGE(PG8_SB(0, 1), b2 + hstep, voffB);
            PG8_WAIT_V(6); PG8_BAR; PG8_MMA(1, 1, At, B1); PG8_BAR;
            PG8_LDB(B0, 1, 0); PG8_SCHED; PG8_LDA(At, 1, 0); PG8_STAGE(PG8_SA(0, 1), a2 + hstep, voffA);
            PG8_WAIT_L(8); PG8_BAR; PG8_WAIT_L(0); PG8_MMA(0, 0, At, B0); PG8_BAR; PG8_SCHED;
            PG8_LDB(B1, 1, 1); PG8_STAGE(PG8_SB(1, 0), b3, voffB);
            PG8_BAR; PG8_WAIT_L(0); PG8_MMA(0, 1, At, B1); PG8_BAR;
            PG8_LDA(At, 1, 1); PG8_STAGE(PG8_SA(1, 0), a3, voffA);
            PG8_BAR; PG8_WAIT_L(0); PG8_MMA(1, 0, At, B0); PG8_BAR; PG8_SCHED;
            PG8_STAGE(PG8_SB(1, 1), b3 + hstep, voffB);
            PG8_WAIT_V(6); PG8_BAR; PG8_MMA(1, 1, At, B1); PG8_BAR;
            }
        }
        if constexpr (ALIGN_EPI) { if (wr == 0) PG8_BAR; }
        if constexpr (!Epi::AFTER_DRAIN) { E(acc, cur, wr, wc, fr, fq); S.done(cur); }
        if (!has_next) break;
        if constexpr (!Epi::CHAIN) {
#pragma unroll
        for (int a = 0; a < 2; ++a)
#pragma unroll
            for (int b = 0; b < 2; ++b)
#pragma unroll
                for (int m = 0; m < 4; ++m)
#pragma unroll
                    for (int n = 0; n < 2; ++n) acc[a][b][m][n] = (f32x4){0.f, 0.f, 0.f, 0.f};
        }
        cur = nxt; cA = nA; cB = nB; ++ui;
        if constexpr (ALIGN_EPI) { if (wr == 1) PG8_BAR; }
    }
    PG8_WAIT_V(0);
    if constexpr (!ALIGN_EPI) { if (wr == 0) PG8_BAR; }
    PG8_BAR;
    if constexpr (Epi::AFTER_DRAIN) { E.fused(acc, cur, wr, wc, fr, fq, lds, wid, lane); S.done(cur); }
#undef PG8_SA
#undef PG8_SB
#undef PG8_STAGE
#undef PG8_LDA
#undef PG8_LDB
#undef PG8_MMA
#undef PG8_WAIT_V
#undef PG8_WAIT_L
#undef PG8_BAR
#undef PG8_SCHED
}
}

namespace pg8 {
__device__ __forceinline__ float sigm(float a) { return __builtin_amdgcn_rcpf(1.f + __builtin_amdgcn_exp2f(-1.4426950408889634f * a)); }
__device__ __forceinline__ float bf_lo(unsigned w) { return __builtin_bit_cast(float, w << 16); }
__device__ __forceinline__ float bf_hi(unsigned w) { return __builtin_bit_cast(float, w & 0xffff0000u); }
constexpr int SG_PITCH = 2048 + 64;

__device__ __forceinline__ float rstd_row(const float* rowp, int row) {
    const f32x4* p = (const f32x4*)(rowp + (size_t)row * 16); const f32x4 a = p[0], b = p[1], c = p[2], d = p[3];
    const float s = (((a[0] + a[1]) + (a[2] + a[3])) + ((b[0] + b[1]) + (b[2] + b[3]))) + (((c[0] + c[1]) + (c[2] + c[3])) + ((d[0] + d[1]) + (d[2] + d[3])));
    return 1.0f / sqrtf(s * (1.0f / 1024.0f) + 1e-6f);
}
template <bool NORM> struct EpiSwiGLU {
    static constexpr bool PERM = true, AFTER_DRAIN = false, CHAIN = false;
    bf16_t* O; int ldc; const PG8_LAS float* rsl; const PG8_LAS float* bl;
    __device__ __forceinline__ void operator()(const f32x4 (&acc)[2][2][4][2], const Unit& u, int wr, int wc, int fr, int fq) const {
        const int row0 = u.pm * BM + wr * 64 + fr, col0 = u.pn * HALF + wc * 32 + 8 * fq;
        f32x4 bv[2][2];
        if (NORM) {
#pragma unroll
            for (int bj = 0; bj < 2; ++bj)
#pragma unroll
                for (int n = 0; n < 2; ++n) bv[bj][n] = *(const PG8_LAS f32x4*)(bl + (u.pn >> 2) * BM + bj * HALF + wc * 32 + 8 * fq + 4 * n);
        }
#pragma unroll
        for (int ai = 0; ai < 2; ++ai)
#pragma unroll
            for (int m = 0; m < 4; ++m) {
                const int row = row0 + ai * HALF + m * 16;
                bf16_t* p = O + (size_t)row * ldc + col0;
                float rs = 1.f; if (NORM) rs = rsl[wr * 64 + fr + ai * HALF + m * 16];
                float v[8];
#pragma unroll
                for (int n = 0; n < 2; ++n)
#pragma unroll
                    for (int j = 0; j < 4; ++j) { float a = acc[ai][0][m][n][j], b = acc[ai][1][m][n][j];
                        if (NORM) { a = a * rs + bv[0][n][j]; b = b * rs + bv[1][n][j]; }
                        v[4 * n + j] = (a * b) * __builtin_amdgcn_rcpf(1.0f + __builtin_amdgcn_exp2f(-a)); }
                u32x4 w; w.x = cvt_pk_bf16(v[0], v[1]); w.y = cvt_pk_bf16(v[2], v[3]); w.z = cvt_pk_bf16(v[4], v[5]); w.w = cvt_pk_bf16(v[6], v[7]);
                *(u32x4*)p = w;
            }
    }
};

template <bool BASE_BF16, bool OUT_BF16> struct EpiRes2 {
    static constexpr bool PERM = true, AFTER_DRAIN = false, CHAIN = false;
    const void* base; void* out; const float* gate; float coef; float* rowp;
    __device__ __forceinline__ void operator()(const f32x4 (&acc)[2][2][4][2], const Unit& u, int wr, int wc, int fr, int fq) const {
        const float* g = gate + (u.pm >> 5) * 9216;
        const int row0 = u.pm * BM + wr * 64 + fr, col0 = u.pn * BM + wc * 32 + 8 * fq;
        f32x4 gv[2][2];
#pragma unroll
        for (int bj = 0; bj < 2; ++bj)
#pragma unroll
            for (int n = 0; n < 2; ++n) gv[bj][n] = *(const f32x4*)(g + col0 + bj * HALF + 4 * n) * coef;
#pragma unroll
        for (int ai = 0; ai < 2; ++ai)
#pragma unroll
            for (int m = 0; m < 4; ++m) {
                const int row = row0 + ai * HALF + m * 16; const size_t off = (size_t)row * 1024 + col0;
                f32x4 b0[2], b1[2];
#pragma unroll
                for (int bj = 0; bj < 2; ++bj) {
                    if (BASE_BF16) { const u32x4 t = *(const u32x4*)((const bf16_t*)base + off + bj * HALF);
                        b0[bj] = (f32x4){bf_lo(t.x), bf_hi(t.x), bf_lo(t.y), bf_hi(t.y)}; b1[bj] = (f32x4){bf_lo(t.z), bf_hi(t.z), bf_lo(t.w), bf_hi(t.w)}; }
                    else { b0[bj] = *(const f32x4*)((const float*)base + off + bj * HALF); b1[bj] = *(const f32x4*)((const float*)base + off + bj * HALF + 4); }
                }
                float ss = 0.f;
#pragma unroll
                for (int bj = 0; bj < 2; ++bj) {
                    const f32x4 v0 = b0[bj] + gv[bj][0] * acc[ai][bj][m][0], v1 = b1[bj] + gv[bj][1] * acc[ai][bj][m][1];
                    if (OUT_BF16) {
                        u32x4 w; w.x = cvt_pk_bf16(v0[0], v0[1]); w.y = cvt_pk_bf16(v0[2], v0[3]); w.z = cvt_pk_bf16(v1[0], v1[1]); w.w = cvt_pk_bf16(v1[2], v1[3]);
                        *(u32x4*)((bf16_t*)out + off + bj * HALF) = w;
                        ss += ((v0[0] * v0[0] + v0[1] * v0[1]) + (v0[2] * v0[2] + v0[3] * v0[3])) + ((v1[0] * v1[0] + v1[1] * v1[1]) + (v1[2] * v1[2] + v1[3] * v1[3]));
                    } else { *(f32x4*)((float*)out + off + bj * HALF) = v0; *(f32x4*)((float*)out + off + bj * HALF + 4) = v1; }
                }
                if (OUT_BF16) { ss += __shfl_xor(ss, 16); ss += __shfl_xor(ss, 32); if (fq == 0) rowp[(size_t)row * 16 + u.pn * 4 + wc] = ss; }
            }
    }
};

struct EpiWin {
    static constexpr bool PERM = true, AFTER_DRAIN = false, CHAIN = false;
    bf16_t *Q, *Kb, *V, *U, *SG; const PG8_LAS float* qkg; const PG8_LAS float* rsl; const PG8_LAS float* bl;
    __device__ __forceinline__ void operator()(const f32x4 (&acc)[2][2][4][2], const Unit& u, int wr, int wc, int fr, int fq) const {
        const int pn = u.pn, row0 = u.pm * BM + wr * 64 + fr;
        f32x4 bv[2][2];
#pragma unroll
        for (int bj = 0; bj < 2; ++bj)
#pragma unroll
            for (int n = 0; n < 2; ++n) bv[bj][n] = *(const PG8_LAS f32x4*)(bl + (pn >> 2) * BM + bj * HALF + wc * 32 + 8 * fq + 4 * n);
        f32x4 gv[2][2];
        if (pn < 4) { const PG8_LAS float* gain = qkg + (pn < 2 ? 0 : 64) + 8 * fq;
#pragma unroll
            for (int bj = 0; bj < 2; ++bj)
#pragma unroll
                for (int n = 0; n < 2; ++n) gv[bj][n] = *(const PG8_LAS f32x4*)(gain + 32 * bj + 4 * n); }
#pragma unroll
        for (int ai = 0; ai < 2; ++ai)
#pragma unroll
            for (int m = 0; m < 4; ++m) {
                const int row = row0 + ai * HALF + m * 16;
                const float rsn = rsl[wr * 64 + fr + ai * HALF + m * 16];
                f32x4 z[2][2];
#pragma unroll
                for (int bj = 0; bj < 2; ++bj)
#pragma unroll
                    for (int n = 0; n < 2; ++n) z[bj][n] = acc[ai][bj][m][n] * rsn + bv[bj][n];
                if (pn < 4) {
                    float ss = 0.f;
#pragma unroll
                    for (int bj = 0; bj < 2; ++bj)
#pragma unroll
                        for (int n = 0; n < 2; ++n) { const f32x4 x = z[bj][n]; ss += (x[0] * x[0] + x[1] * x[1]) + (x[2] * x[2] + x[3] * x[3]); }
                    ss += __shfl_xor(ss, 16); ss += __shfl_xor(ss, 32);
                    const float rs = 1.0f / sqrtf(ss * (1.0f / 64.0f) + 1e-6f);
                    bf16_t* p = (pn < 2 ? Q : Kb) + 256 * (pn & 1) + 64 * wc + 8 * fq + (size_t)row * 512;
#pragma unroll
                    for (int bj = 0; bj < 2; ++bj) { const f32x4 v0 = z[bj][0] * rs * gv[bj][0], v1 = z[bj][1] * rs * gv[bj][1];
                        u32x4 w; w.x = cvt_pk_bf16(v0[0], v0[1]); w.y = cvt_pk_bf16(v0[2], v0[3]); w.z = cvt_pk_bf16(v1[0], v1[1]); w.w = cvt_pk_bf16(v1[2], v1[3]);
                        *(u32x4*)(p + 32 * bj) = w; }
                } else if (pn < 8) {
                    bf16_t* p = (pn < 6 ? V : U) + 256 * (pn & 1) + 32 * wc + 8 * fq + (size_t)row * 512;
#pragma unroll
                    for (int bj = 0; bj < 2; ++bj) { const f32x4 v0 = z[bj][0], v1 = z[bj][1];
                        u32x4 w; w.x = cvt_pk_bf16(v0[0], v0[1]); w.y = cvt_pk_bf16(v0[2], v0[3]); w.z = cvt_pk_bf16(v1[0], v1[1]); w.w = cvt_pk_bf16(v1[2], v1[3]);
                        *(u32x4*)(p + bj * HALF) = w; }
                } else {
                    unsigned char* p = (unsigned char*)SG + 256 * (pn - 8) + 32 * wc + 8 * fq + (size_t)row * SG_PITCH;
#pragma unroll
                    for (int bj = 0; bj < 2; ++bj) { const f32x4 v0 = z[bj][0], v1 = z[bj][1];
                        u32x2 w;
                        w.x = (unsigned)(sigm(v0[0]) * 255.0f + 0.5f) | ((unsigned)(sigm(v0[1]) * 255.0f + 0.5f) << 8) | ((unsigned)(sigm(v0[2]) * 255.0f + 0.5f) << 16) | ((unsigned)(sigm(v0[3]) * 255.0f + 0.5f) << 24);
                        w.y = (unsigned)(sigm(v1[0]) * 255.0f + 0.5f) | ((unsigned)(sigm(v1[1]) * 255.0f + 0.5f) << 8) | ((unsigned)(sigm(v1[2]) * 255.0f + 0.5f) << 16) | ((unsigned)(sigm(v1[3]) * 255.0f + 0.5f) << 24);
                        *(u32x2*)(p + bj * HALF) = w; }
                }
            }
    }
};

template <bool ACCUM> struct EpiGate {
    static constexpr bool PERM = true, AFTER_DRAIN = false, CHAIN = false;
    bf16_t* T; const bf16_t* SG; int goff;
    __device__ __forceinline__ void operator()(const f32x4 (&acc)[2][2][4][2], const Unit& u, int wr, int wc, int fr, int fq) const {
        const int row0 = u.pm * BM + wr * 64 + fr, col0 = u.pn * BM + wc * 32 + 8 * fq;
#pragma unroll
        for (int ai = 0; ai < 2; ++ai)
#pragma unroll
            for (int m = 0; m < 4; ++m) { const size_t row = (size_t)(row0 + ai * HALF + m * 16);
#pragma unroll
                for (int bj = 0; bj < 2; ++bj) {
                    const u32x2 g = *(const u32x2*)((const unsigned char*)SG + row * SG_PITCH + goff + col0 + bj * HALF);
                    const f32x4 a0 = acc[ai][bj][m][0], a1 = acc[ai][bj][m][1];
                    const float q = 1.0f / 255.0f;
                    float v[8] = { (float)(g.x & 255u) * q * a0[0], (float)((g.x >> 8) & 255u) * q * a0[1], (float)((g.x >> 16) & 255u) * q * a0[2], (float)(g.x >> 24) * q * a0[3], (float)(g.y & 255u) * q * a1[0], (float)((g.y >> 8) & 255u) * q * a1[1], (float)((g.y >> 16) & 255u) * q * a1[2], (float)(g.y >> 24) * q * a1[3] };
                    bf16_t* p = T + row * 1024 + col0 + bj * HALF;
                    if (ACCUM) { const u32x4 t = *(const u32x4*)p;
                        v[0] += bf_lo(t.x); v[1] += bf_hi(t.x); v[2] += bf_lo(t.y); v[3] += bf_hi(t.y); v[4] += bf_lo(t.z); v[5] += bf_hi(t.z); v[6] += bf_lo(t.w); v[7] += bf_hi(t.w); }
                    u32x4 w; w.x = cvt_pk_bf16(v[0], v[1]); w.y = cvt_pk_bf16(v[2], v[3]); w.z = cvt_pk_bf16(v[4], v[5]); w.w = cvt_pk_bf16(v[6], v[7]);
                    *(u32x4*)p = w; } }
    }
};
struct ChainOrder {
    StaticOrder so;
    __device__ bool next(int i, Unit& u) const { if (i > 1 || !so.next(0, u)) return false; if (i == 1) { u.pm += 64; u.pn += 4; } return true; }
    __device__ __forceinline__ void a_ready(const Unit&) const {}
    __device__ __forceinline__ void done(const Unit&) const {}
};
struct EpiChain {
    static constexpr bool PERM = true, AFTER_DRAIN = false, CHAIN = true;
    bf16_t* T; const unsigned char* SG;
    __device__ __forceinline__ void operator()(f32x4 (&acc)[2][2][4][2], const Unit& u, int wr, int wc, int fr, int fq) const {
        const bool second = u.pm >= 64; const int pm = second ? u.pm - 64 : u.pm, pn = second ? u.pn - 4 : u.pn;
        const int row0 = pm * BM + wr * 64 + fr, col0 = pn * BM + wc * 32 + 8 * fq;
#pragma unroll
        for (int ai = 0; ai < 2; ++ai)
#pragma unroll
            for (int m = 0; m < 4; ++m) { const size_t row = (size_t)(row0 + ai * HALF + m * 16);
#pragma unroll
                for (int bj = 0; bj < 2; ++bj) {
                    const u32x2 gb = *(const u32x2*)(SG + row * SG_PITCH + 1024 + col0 + bj * HALF);
                    float fb[8] = { (float)(gb.x & 255u), (float)((gb.x >> 8) & 255u), (float)((gb.x >> 16) & 255u), (float)(gb.x >> 24), (float)(gb.y & 255u), (float)((gb.y >> 8) & 255u), (float)((gb.y >> 16) & 255u), (float)(gb.y >> 24) };
#pragma unroll
                    for (int j = 0; j < 8; ++j) fb[j] = fmaxf(fb[j], 1.0f);
                    if (!second) {
                        const u32x2 ga = *(const u32x2*)(SG + row * SG_PITCH + col0 + bj * HALF);
                        const float fa[8] = { (float)(ga.x & 255u), (float)((ga.x >> 8) & 255u), (float)((ga.x >> 16) & 255u), (float)(ga.x >> 24), (float)(ga.y & 255u), (float)((ga.y >> 8) & 255u), (float)((ga.y >> 16) & 255u), (float)(ga.y >> 24) };
#pragma unroll
                        for (int j = 0; j < 4; ++j) { acc[ai][bj][m][0][j] *= fa[j] * __builtin_amdgcn_rcpf(fb[j]); acc[ai][bj][m][1][j] *= fa[4 + j] * __builtin_amdgcn_rcpf(fb[4 + j]); }
                    } else {
                        const float q = 1.0f / 255.0f; const f32x4 a0 = acc[ai][bj][m][0], a1 = acc[ai][bj][m][1];
                        u32x4 w; w.x = cvt_pk_bf16(fb[0] * q * a0[0], fb[1] * q * a0[1]); w.y = cvt_pk_bf16(fb[2] * q * a0[2], fb[3] * q * a0[3]);
                        w.z = cvt_pk_bf16(fb[4] * q * a1[0], fb[5] * q * a1[1]); w.w = cvt_pk_bf16(fb[6] * q * a1[2], fb[7] * q * a1[3]);
                        *(u32x4*)(T + row * 1024 + col0 + bj * HALF) = w;
                    }
                } }
    }
};
}

#define GAS __attribute__((address_space(1)))
#define LAS __attribute__((address_space(3)))
typedef unsigned short bf16;
typedef unsigned v4u __attribute__((ext_vector_type(4)));
typedef unsigned v2u __attribute__((ext_vector_type(2)));
typedef float f32x4 __attribute__((ext_vector_type(4)));
typedef float f32x16 __attribute__((ext_vector_type(16)));
typedef short bf16x8 __attribute__((ext_vector_type(8)));
typedef short __attribute__((may_alias)) short_a;
typedef short v4i16_t __attribute__((ext_vector_type(4)));
typedef v4u __attribute__((may_alias)) v4u_a;

#ifndef MK_PER_PHASE
#define MK_PER_PHASE 0
#endif
constexpr int NPHASE = 10;
constexpr int BATCH = 2, SEQ = 8192, DM = 1024, M = BATCH * SEQ, DFF = 2816, NFF = 2 * DFF, NIN = 4096, AW = 512, NADA = 9 * DM, NCHUNK = SEQ / 64;
constexpr int NBIAS = NIN + NFF;
constexpr size_t MiB = 1u << 20;
constexpr size_t WS_MOD = 1 * MiB;
constexpr size_t WS_W1 = 2 * MiB, WS_W2 = 13 * MiB, WS_WIN = 19 * MiB  , WS_WA = 35 * MiB, WS_WC = 36 * MiB, WS_WO = 37 * MiB, WS_W3 = 39 * MiB  , WS_W4 = 61 * MiB;
static_assert(WS_WC == WS_WA + (size_t)DM * AW * 2, "Wa and Wc stacked");
constexpr size_t WS_XN = 67 * MiB;
constexpr size_t WS_ACT = 99 * MiB;
constexpr size_t WS_Q = 99 * MiB, WS_K = 115 * MiB, WS_V = 131 * MiB, WS_U = 147 * MiB, WS_SG = 163 * MiB;
constexpr size_t WS_XB2 = 99 * MiB;
constexpr size_t WS_ACT2 = 131 * MiB;
constexpr size_t WS_ROWP2 = 230 * MiB, WS_ROWP3 = 231 * MiB;
constexpr size_t WS_BIASP = 232 * MiB;
constexpr size_t WS_BIAS = 234 * MiB;
constexpr size_t WS_END = 235 * MiB;
static_assert(WS_SG + (size_t)M * pg8::SG_PITCH <= WS_ROWP2, "gate buffer fits below the row-sum tables");
constexpr int LDS_BYTES = 147456;

__device__ __forceinline__ unsigned f2bf(float f) { unsigned u = __builtin_bit_cast(unsigned, f); return (u + 0x7fffu + ((u >> 16) & 1u)) >> 16; }
__device__ __forceinline__ unsigned pk2(float lo, float hi) { return f2bf(lo) | (f2bf(hi) << 16); }
__device__ __forceinline__ float wave_sum(float v) {
#pragma unroll
    for (int o = 1; o < 64; o <<= 1) v += __shfl_xor(v, o);
    return v;
}
__device__ __forceinline__ float silu_f(float a) { return a / (1.f + __expf(-a)); }

__device__ __forceinline__ int dst_row0(int mode, int n0) {
    if (mode == 1) { const int hb = n0 >= DFF ? 1 : 0, j = n0 - hb * DFF; return 256 * (j >> 7) + 128 * hb + (j & 127); }
    if (mode == 2 && n0 < 1024) { const int pn = n0 >> 8, c = n0 & 255, hh = c >> 6, e = c & 63; return 256 * pn + 128 * (e >> 5) + 32 * hh + (e & 31); }
    return n0;
}
template <bool SCALED> __device__ __forceinline__ void transpose_item_t(const float* W, int K, int N, bf16* WT, int mode, LAS float* scr, int item, int lane, const float* gvec, const float* scv, const float* shv, float* biasp) {
    const int nblk = N / 32, kb = item / nblk, nb = item % nblk, k0 = 64 * kb, n0 = 32 * nb, d0 = dst_row0(mode, n0);
    float tv[32];
#pragma unroll
    for (int i = 0; i < 32; ++i) tv[i] = W[(size_t)(k0 + 2 * i + (lane >> 5)) * N + n0 + (lane & 31)];
    if (mode == 1) {
        const float fsc = n0 < DFF ? 1.4426950408889634f : 0.6931471805599453f;
#pragma unroll
        for (int i = 0; i < 32; ++i) tv[i] *= fsc;
    }
    if (SCALED) {
        float part = 0.f;
#pragma unroll
        for (int i = 0; i < 32; ++i) { const int k = k0 + 2 * i + (lane >> 5); part += tv[i] * shv[k]; tv[i] *= gvec[k] * (1.0f + scv[k]); }
        part += __shfl_xor(part, 32);
        if (lane < 32) biasp[(size_t)kb * NBIAS + d0 + lane] = part;
    }
#pragma unroll
    for (int i = 0; i < 32; ++i) scr[(2 * i + (lane >> 5)) * 33 + (lane & 31)] = tv[i];
    asm volatile("s_waitcnt lgkmcnt(0)" ::: "memory");
    const int c = lane & 7;
#pragma unroll
    for (int j = 0; j < 4; ++j) { const int n = (lane >> 3) + 8 * j; const LAS float* s = scr + (8 * c) * 33 + n;
        v4u o; o.x = pk2(s[0 * 33], s[1 * 33]); o.y = pk2(s[2 * 33], s[3 * 33]); o.z = pk2(s[4 * 33], s[5 * 33]); o.w = pk2(s[6 * 33], s[7 * 33]);
        *(v4u*)(WT + (size_t)(d0 + n) * K + k0 + 8 * c) = o; }
    asm volatile("s_waitcnt lgkmcnt(0)" ::: "memory");
}
__device__ __forceinline__ void transpose_item(const float* W, int K, int N, bf16* WT, int mode, LAS float* scr, int item, int lane) { transpose_item_t<false>(W, K, N, WT, mode, scr, item, lane, nullptr, nullptr, nullptr, nullptr); }

__device__ __forceinline__ void norm_row(const float* xrow, bf16* orow, const float* g, const float* sh, const float* sc, int lane) {
    const f32x4* xr = (const f32x4*)xrow + lane;
    f32x4 v[4]; float s = 0.f;
#pragma unroll
    for (int j = 0; j < 4; ++j) { v[j] = xr[64 * j]; s += (v[j].x * v[j].x + v[j].y * v[j].y) + (v[j].z * v[j].z + v[j].w * v[j].w); }
    const float rs = 1.0f / sqrtf(wave_sum(s) * (1.f / DM) + 1e-6f);
    unsigned long long* o8 = (unsigned long long*)orow + lane;
#pragma unroll
    for (int j = 0; j < 4; ++j) {
        const f32x4 gg = ((const f32x4*)g)[64 * j + lane], s1 = ((const f32x4*)sc)[64 * j + lane], s0 = ((const f32x4*)sh)[64 * j + lane];
        const f32x4 h = v[j] * rs * gg * (s1 + 1.0f) + s0;
        o8[64 * j] = (unsigned long long)pk2(h.x, h.y) | ((unsigned long long)pk2(h.z, h.w) << 32);
    }
}

__device__ __forceinline__ void attn_wave(LAS unsigned char* wl, const bf16* Q, const bf16* K, const bf16* V, bf16* O, const float* relb, int b, int n, int h, int lane) {
    const int r32 = lane & 31, hf = lane >> 5;
    const int trb = (4 * hf + ((lane & 15) >> 2)) * 192 + (16 * ((lane >> 4) & 1) + 4 * (lane & 3)) * 2;
    LAS float* biasL = (LAS float*)(wl + 6144);
    for (int i = lane; i < 257; i += 64) biasL[i] = relb[h * 257 + i] * 1.4426950408889634f;
    const size_t tq0 = (size_t)b * SEQ + (size_t)n * 64;
    bf16x8 qf[2][4];
#pragma unroll
    for (int qb = 0; qb < 2; ++qb)
#pragma unroll
        for (int ks = 0; ks < 4; ++ks) qf[qb][ks] = *(const bf16x8*)(Q + (tq0 + 32 * qb + r32) * AW + h * 64 + 16 * ks + 8 * hf);
    f32x16 o[2][2];
#pragma unroll
    for (int db = 0; db < 2; ++db)
#pragma unroll
        for (int qb = 0; qb < 2; ++qb)
#pragma unroll
            for (int i = 0; i < 16; ++i) o[db][qb][i] = 0.f;
    float mrun[2] = {-INFINITY, -INFINITY}, lrun[2] = {0.f, 0.f};
    const float CL2 = 0.125f * 1.4426950408889634f;
    const int kk0 = n >= 8 ? 0 : 2 * (8 - n);
    const bf16* kp = K + ((size_t)b * SEQ + (size_t)(n - 8) * 64 + r32) * AW + h * 64 + 8 * hf;
    const bf16* vp = V + ((size_t)b * SEQ + (size_t)(n - 8) * 64 + (lane >> 3)) * AW + h * 64 + 8 * (lane & 7);
    bf16x8 kf[4]; v4u vr[4];
#pragma unroll
    for (int ks = 0; ks < 4; ++ks) kf[ks] = *(const bf16x8*)(kp + (size_t)kk0 * 32 * AW + 16 * ks);
#pragma unroll
    for (int i = 0; i < 4; ++i) vr[i] = *(const v4u*)(vp + ((size_t)kk0 * 32 + 8 * i) * AW);
    for (int kk = kk0; kk < 18; ++kk) {
        f32x16 s[2];
#pragma unroll
        for (int qb = 0; qb < 2; ++qb) {
#pragma unroll
            for (int i = 0; i < 16; ++i) s[qb][i] = 0.f;
#pragma unroll
            for (int ks = 0; ks < 4; ++ks) s[qb] = __builtin_amdgcn_mfma_f32_32x32x16_bf16(kf[ks], qf[qb][ks], s[qb], 0, 0, 0);
        }
#pragma unroll
        for (int i = 0; i < 4; ++i) *(LAS v4u_a*)(wl + ((lane >> 3) + 8 * i) * 192 + 16 * (lane & 7)) = vr[i];
        if (kk + 1 < 18) {
#pragma unroll
            for (int ks = 0; ks < 4; ++ks) kf[ks] = *(const bf16x8*)(kp + (size_t)(kk + 1) * 32 * AW + 16 * ks);
#pragma unroll
            for (int i = 0; i < 4; ++i) vr[i] = *(const v4u*)(vp + ((size_t)(kk + 1) * 32 + 8 * i) * AW);
        }
        const int dbase = 512 - 32 * kk - 4 * hf + r32;
        float mx[2];
        if (kk < 12) {
            const float cb = biasL[256];
#pragma unroll
            for (int qb = 0; qb < 2; ++qb) { float m_ = -INFINITY;
#pragma unroll
                for (int i = 0; i < 16; ++i) { const float val = s[qb][i] * CL2 + cb; s[qb][i] = val; m_ = fmaxf(m_, val); }
                mx[qb] = m_; }
        } else {
#pragma unroll
            for (int qb = 0; qb < 2; ++qb) { float m_ = -INFINITY;
#pragma unroll
                for (int i = 0; i < 16; ++i) {
                    int dist = dbase + 32 * qb - (8 * (i >> 2) + (i & 3)); dist = dist > 128 ? 128 : dist;
                    const float val = s[qb][i] * CL2 + biasL[dist + 128];
                    s[qb][i] = val; m_ = fmaxf(m_, val);
                }
                mx[qb] = m_; }
        }
        mx[0] = fmaxf(mx[0], __shfl_xor(mx[0], 32)); mx[1] = fmaxf(mx[1], __shfl_xor(mx[1], 32));
        if (__any((mx[0] > mrun[0] + 8.0f) || (mx[1] > mrun[1] + 8.0f))) {
#pragma unroll
            for (int qb = 0; qb < 2; ++qb) {
                const float mnew = fmaxf(mrun[qb], mx[qb]), alpha = __builtin_amdgcn_exp2f(mrun[qb] - mnew);
                mrun[qb] = mnew; lrun[qb] *= alpha;
#pragma unroll
                for (int db = 0; db < 2; ++db)
#pragma unroll
                    for (int i = 0; i < 16; ++i) o[db][qb][i] *= alpha;
            }
        }
#pragma unroll
        for (int qb = 0; qb < 2; ++qb) {
            float sum = 0.f;
#pragma unroll
            for (int i = 0; i < 16; ++i) { const float p = __builtin_amdgcn_exp2f(s[qb][i] - mrun[qb]); s[qb][i] = p; sum += p; }
            sum += __shfl_xor(sum, 32);
            lrun[qb] += sum;
        }
#pragma unroll
        for (int j2 = 0; j2 < 2; ++j2) {
            bf16x8 pf[2];
#pragma unroll
            for (int qb = 0; qb < 2; ++qb) {
                const unsigned p0 = pg8::cvt_pk_bf16(s[qb][8 * j2 + 0], s[qb][8 * j2 + 1]), p1 = pg8::cvt_pk_bf16(s[qb][8 * j2 + 2], s[qb][8 * j2 + 3]);
                const unsigned p2 = pg8::cvt_pk_bf16(s[qb][8 * j2 + 4], s[qb][8 * j2 + 5]), p3 = pg8::cvt_pk_bf16(s[qb][8 * j2 + 6], s[qb][8 * j2 + 7]);
                pf[qb] = __builtin_bit_cast(bf16x8, (v4u){p0, p1, p2, p3});
            }
#pragma unroll
            for (int db = 0; db < 2; ++db) {
                const v4i16_t lo = __builtin_amdgcn_ds_read_tr16_b64_v4i16((LAS v4i16_t*)(wl + trb + (16 * j2) * 192 + 64 * db));
                const v4i16_t hi = __builtin_amdgcn_ds_read_tr16_b64_v4i16((LAS v4i16_t*)(wl + trb + (16 * j2 + 8) * 192 + 64 * db));
                const bf16x8 vf = {lo[0], lo[1], lo[2], lo[3], hi[0], hi[1], hi[2], hi[3]};
#pragma unroll
                for (int qb = 0; qb < 2; ++qb) o[db][qb] = __builtin_amdgcn_mfma_f32_32x32x16_bf16(vf, pf[qb], o[db][qb], 0, 0, 0);
            }
        }
    }
#pragma unroll
    for (int qb = 0; qb < 2; ++qb) {
        const float inv = 1.0f / lrun[qb];
        bf16* orow = O + (tq0 + 32 * qb + r32) * AW + h * 64 + 4 * hf;
#pragma unroll
        for (int db = 0; db < 2; ++db)
#pragma unroll
            for (int g = 0; g < 4; ++g) {
                v2u w; w.x = pg8::cvt_pk_bf16(o[db][qb][4 * g + 0] * inv, o[db][qb][4 * g + 1] * inv); w.y = pg8::cvt_pk_bf16(o[db][qb][4 * g + 2] * inv, o[db][qb][4 * g + 3] * inv);
                *(v2u*)(orow + 32 * db + 8 * g) = w;
            }
    }
}

template <int WIN> __device__ __forceinline__ void pool_wave(const bf16* UB, bf16* MIX, int b, int n, int g, int th, int lane) {
    constexpr int R = 7 + WIN;
    const int o = lane & 15, tb = lane >> 4;
    const int s0 = n * 64 + th * 32 + tb * 8;
    const bf16* ub = UB + (size_t)b * SEQ * AW + g * 128 + 8 * o;
    v4u rows[R];
#pragma unroll
    for (int j = 0; j < R; ++j) { int pos = s0 - (WIN - 1) + j; pos = pos < 0 ? 0 : pos; rows[j] = *(const v4u*)(ub + (size_t)pos * AW); }
    float acc[8];
#pragma unroll
    for (int e = 0; e < 8; ++e) acc[e] = 0.f;
#define POOL_UNPACK(f, t, msk) const float f[8] = { pg8::bf_lo(t.x) * msk, pg8::bf_hi(t.x) * msk, pg8::bf_lo(t.y) * msk, pg8::bf_hi(t.y) * msk, pg8::bf_lo(t.z) * msk, pg8::bf_hi(t.z) * msk, pg8::bf_lo(t.w) * msk, pg8::bf_hi(t.w) * msk }
#pragma unroll
    for (int j = 0; j < WIN; ++j) { const float mk = (s0 - (WIN - 1) + j) >= 0 ? 1.f : 0.f; POOL_UNPACK(f, rows[j], mk);
#pragma unroll
        for (int e = 0; e < 8; ++e) acc[e] += f[e]; }
#pragma unroll
    for (int tt = 0; tt < 8; ++tt) {
        const int s = s0 + tt, cnt = (s + 1) < WIN ? (s + 1) : WIN;
        const float inv = 1.0f / (float)cnt;
        POOL_UNPACK(self, rows[tt + WIN - 1], 1.f);
        v4u ov; ov.x = pg8::cvt_pk_bf16(acc[0] * inv - self[0], acc[1] * inv - self[1]); ov.y = pg8::cvt_pk_bf16(acc[2] * inv - self[2], acc[3] * inv - self[3]);
        ov.z = pg8::cvt_pk_bf16(acc[4] * inv - self[4], acc[5] * inv - self[5]); ov.w = pg8::cvt_pk_bf16(acc[6] * inv - self[6], acc[7] * inv - self[7]);
        *(v4u*)(MIX + ((size_t)b * SEQ + s) * AW + g * 128 + 8 * o) = ov;
        if (tt < 7) { const float mk = (s0 - (WIN - 1) + tt) >= 0 ? 1.f : 0.f; POOL_UNPACK(fin, rows[tt + WIN], 1.f); POOL_UNPACK(fout, rows[tt], mk);
#pragma unroll
            for (int e = 0; e < 8; ++e) acc[e] += fin[e] - fout[e]; }
    }
#undef POOL_UNPACK
}

#define XB_TMO      128
#define XB_XCNT(j)  (256  + 64 * (j))
#define XB_XSUB(j)  (1280 + 64 * (j))
#define XB_XGEN(j)  (2304 + 64 * (j))
#define XB_TOP      3328
#define XB_TOPGEN   3392
#define XCD_BAR_WORDS 3456
#define XB_SPIN_CAP (1u << 18)

__device__ __forceinline__ unsigned xb_ld(unsigned* p)              { return __hip_atomic_load(p, __ATOMIC_RELAXED, __HIP_MEMORY_SCOPE_AGENT); }
__device__ __forceinline__ unsigned xb_add(unsigned* p, unsigned v) { return __hip_atomic_fetch_add(p, v, __ATOMIC_RELAXED, __HIP_MEMORY_SCOPE_AGENT); }
__device__ __forceinline__ unsigned xb_xcc_id() { return (unsigned)__builtin_amdgcn_s_getreg((3 << 11) | 20) & 0xFu; }
#define XB_SPIN(cond, bar) do { unsigned _sp = 0; while (cond) { __builtin_amdgcn_s_sleep(1); \
    if ((++_sp & 255u) == 0u) { if (xb_ld(&(bar)[XB_TMO])) break; if (_sp > XB_SPIN_CAP) { atomicAdd(&(bar)[XB_TMO], 1u); break; } } } } while (0)

struct XcdBarrier {
    unsigned* bar; unsigned x;
    volatile LAS unsigned* st;
};

__device__ __forceinline__ XcdBarrier xcd_barrier_post(unsigned* bar, volatile LAS unsigned* st) {
    XcdBarrier b; b.bar = bar; b.x = xb_xcc_id(); b.st = st;
    if (threadIdx.x == 0) (void)xb_add(&bar[XB_XCNT(b.x)], 1u);
    return b;
}
__device__ __forceinline__ void xcd_barrier_complete(unsigned* bar, unsigned x, unsigned& nloc, unsigned& nx) {
    const unsigned G = gridDim.x * gridDim.y * gridDim.z;
    unsigned sum, cnt, mine, sp = 0u;
    for (;;) {
        sum = 0u; cnt = 0u; mine = 0u;
#pragma unroll
        for (unsigned j = 0; j < 16; ++j) { const unsigned c = xb_ld(&bar[XB_XCNT(j)]); sum += c; cnt += (c > 0u) ? 1u : 0u; mine = (j == x) ? c : mine; }
        if (sum == G) break;
        __builtin_amdgcn_s_sleep(1);
        if ((++sp & 255u) == 0u) { if (xb_ld(&bar[XB_TMO])) break; if (sp > XB_SPIN_CAP) { atomicAdd(&bar[XB_TMO], 1u); break; } }
    }
    nloc = mine > 0u ? mine : 1u; nx = cnt > 0u ? cnt : 1u;
}

__device__ __forceinline__ void xcd_barrier(const XcdBarrier& b) {
    asm volatile("s_waitcnt vmcnt(0)" ::: "memory");
    __syncthreads();
    if (threadIdx.x == 0) {
        unsigned* bar = b.bar;
        __builtin_amdgcn_s_waitcnt(0);
        unsigned nloc = b.st[0], nx = b.st[1];
        if (nloc == 0u) { xcd_barrier_complete(bar, b.x, nloc, nx); b.st[0] = nloc; b.st[1] = nx; }
        const unsigned old = xb_add(&bar[XB_XSUB(b.x)], 1u);
        const unsigned gen = old / nloc;
        if (old + 1u == (gen + 1u) * nloc) {
            __builtin_amdgcn_fence(__ATOMIC_RELEASE, "agent");
            asm volatile("s_waitcnt vmcnt(0)" ::: "memory");
            const unsigned og = xb_add(&bar[XB_TOP], 1u);
            const unsigned tg = og / nx;
            if (og + 1u == (tg + 1u) * nx) xb_add(&bar[XB_TOPGEN], 1u);
            else XB_SPIN(xb_ld(&bar[XB_TOPGEN]) == tg, bar);
            __builtin_amdgcn_fence(__ATOMIC_ACQUIRE, "agent");
            xb_add(&bar[XB_XGEN(b.x)], 1u);
            asm volatile("s_waitcnt vmcnt(0)" ::: "memory");
        } else {
            XB_SPIN(xb_ld(&bar[XB_XGEN(b.x)]) == gen, bar);
            __builtin_amdgcn_fence(__ATOMIC_ACQUIRE, "agent");
            asm volatile("s_waitcnt vmcnt(0)" ::: "memory");
        }
    }
    __syncthreads();
}

__device__ __forceinline__ void group_barrier(unsigned* cnt, unsigned target) {
    asm volatile("s_waitcnt vmcnt(0)" ::: "memory");
    __syncthreads();
    if (threadIdx.x == 0) {
        (void)xb_add(cnt, 1u);
        unsigned sp = 0u;
        while (xb_ld(cnt) < target) { __builtin_amdgcn_s_sleep(1); if (++sp > (1u << 22)) break; }
        __builtin_amdgcn_fence(__ATOMIC_ACQUIRE, "agent");
        asm volatile("s_waitcnt vmcnt(0)" ::: "memory");
    }
    __syncthreads();
}

struct Args { const float* in[20]; float* out; unsigned char* ws; int ph_lo, ph_hi; };

__global__ void __launch_bounds__(512, 2) hybrid_fwd(Args args) {
    extern __shared__ __attribute__((aligned(16))) unsigned char lds_[];
    LAS unsigned char* lds = (LAS unsigned char*)lds_;
    int tid = threadIdx.x, lane = tid & 63; const int wave = __builtin_amdgcn_readfirstlane(tid >> 6);
    const int G = gridDim.x, blk = blockIdx.x;
    const int gw = blk * 8 + wave, NGW = G * 8;
    cg::grid_group grid = cg::this_grid();
    unsigned char* ws = args.ws;
    const float* x = args.in[0]; const float* cvec = args.in[1]; const float* w_ada = args.in[2]; const float* b_ada = args.in[3];
    const float* g_ffn1 = args.in[4]; const float* w_ffn1_in = args.in[5]; const float* w_ffn1_out = args.in[6]; const float* g_mix = args.in[7];
    const float* w_in = args.in[8]; const float* q_gain = args.in[9]; const float* k_gain = args.in[10]; const float* rel_bias = args.in[11];
    const float* w_attn_out = args.in[12]; const float* w_pool_group = args.in[13]; const float* pool_scale = args.in[14]; const float* w_pool_out = args.in[15];
    const float* w_o = args.in[16]; const float* g_ffn2 = args.in[17]; const float* w_ffn2_in = args.in[18]; const float* w_ffn2_out = args.in[19];
    float* out = args.out;
    float* mod = (float*)(ws + WS_MOD);
    bf16 *W1 = (bf16*)(ws + WS_W1), *W2 = (bf16*)(ws + WS_W2), *WIN = (bf16*)(ws + WS_WIN), *WA = (bf16*)(ws + WS_WA), *WC = (bf16*)(ws + WS_WC), *WO = (bf16*)(ws + WS_WO), *W3 = (bf16*)(ws + WS_W3), *W4 = (bf16*)(ws + WS_W4);
    bf16 *XN = (bf16*)(ws + WS_XN), *ACT = (bf16*)(ws + WS_ACT), *ACT2 = (bf16*)(ws + WS_ACT2), *QB = (bf16*)(ws + WS_Q), *KB = (bf16*)(ws + WS_K), *VB = (bf16*)(ws + WS_V), *UB = (bf16*)(ws + WS_U), *SG = (bf16*)(ws + WS_SG), *XB2 = (bf16*)(ws + WS_XB2);
    bf16 *XB1 = (bf16*)out, *ATT = (bf16*)out + (size_t)M * DM, *MIX = (bf16*)out + (size_t)M * DM + (size_t)M * AW;
    float *ROWP2 = (float*)(ws + WS_ROWP2), *ROWP3 = (float*)(ws + WS_ROWP3), *BIASP = (float*)(ws + WS_BIASP), *BIAS = (float*)(ws + WS_BIAS);
    bf16* TM = XN;
    const int lo = args.ph_lo, hi = args.ph_hi;
    for (int u = tid; u < (LDS_BYTES - 131072) / 4; u += 512) ((LAS unsigned*)(lds + 131072))[u] = 0u;
    __syncthreads();
    XcdBarrier bar = xcd_barrier_post((unsigned*)ws + 4096, (volatile LAS unsigned*)(lds + 131072 + 352));
    unsigned* const xcctab = (unsigned*)ws + 12288;
    unsigned* const gcnt = (unsigned*)ws + 8192 + 64 * (blk & 63);
    if (tid == 0) __hip_atomic_store(xcctab + blk, xb_xcc_id() + 1u, __ATOMIC_RELAXED, __HIP_MEMORY_SCOPE_AGENT);
    bool grp_local = false; unsigned gepoch = 0u;
    if (lo < 0) grid.sync();
#define IN(k) (lo <= (k) && (k) < hi)
#define OPQ(v) asm volatile("" : "+v"(v))
#define SEAM(k) do { if (IN(k) && IN((k) + 1)) xcd_barrier(bar); } while (0)
#define SEAM_G(k) do { if (IN(k) && IN((k) + 1)) { if (grp_local) { gepoch += 4u; group_barrier(gcnt, gepoch); } else xcd_barrier(bar); } } while (0)

    if (IN(0)) {
        OPQ(lane);
        LAS float* scr = (LAS float*)(lds + wave * 16384);
        constexpr int I_1 = (DM / 64) * (NFF / 32);
        constexpr int I_4 = (DFF / 64) * (DM / 32), I_A0 = (AW / 64) * (DM / 32), I_O0 = (DM / 64) * (DM / 32);
        for (int it = gw; it < I_1 + 2 * I_4 + I_A0 + I_O0; it += NGW) {
            int r = it;
            if (r < I_1) { transpose_item(w_ffn1_in, DM, NFF, W1, 1, scr, r, lane); continue; } r -= I_1;
            if (r < I_4) { transpose_item(w_ffn1_out, DFF, DM, W2, 0, scr, r, lane); continue; } r -= I_4;
            if (r < I_4) { transpose_item(w_ffn2_out, DFF, DM, W4, 0, scr, r, lane); continue; } r -= I_4;
            if (r < I_A0) { transpose_item(w_attn_out, AW, DM, WA, 0, scr, r, lane); continue; } r -= I_A0;
            transpose_item(w_o, DM, DM, WO, 0, scr, r, lane);
        }
        for (int task = gw; task < 2048; task += NGW) {
            const int iq = task >> 4, nb = task & 15, n = nb * 64 + lane, g = iq >> 5, c0 = (iq & 31) * 4;
            const float* wg = w_pool_group + ((size_t)g * 128 + c0) * 128;
#pragma unroll
            for (int e = 0; e < 4; ++e) { scr[lane * 4 + e] = wg[e * 128 + lane] * pool_scale[g * 128 + lane]; scr[(lane + 64) * 4 + e] = wg[e * 128 + 64 + lane] * pool_scale[g * 128 + 64 + lane]; }
            asm volatile("s_waitcnt lgkmcnt(0)" ::: "memory");
            float acc[4] = {0.f, 0.f, 0.f, 0.f};
            const float* wp = w_pool_out + (size_t)g * 128 * DM + n;
#pragma unroll 16
            for (int d = 0; d < 128; ++d) {
                const float p = wp[(size_t)d * DM];
                const f32x4 a = *(const LAS f32x4*)(scr + d * 4);
                acc[0] += a[0] * p; acc[1] += a[1] * p; acc[2] += a[2] * p; acc[3] += a[3] * p;
            }
            v2u o; o.x = pk2(acc[0], acc[1]); o.y = pk2(acc[2], acc[3]);
            *(v2u*)(WC + (size_t)n * AW + g * 128 + c0) = o;
            asm volatile("s_waitcnt lgkmcnt(0)" ::: "memory");
        }
        LAS float* red = (LAS float*)(lds + 12288);
        for (int cb = blk; cb < 256; cb += G) {
            const int c4 = lane & 15, ks = lane >> 4;
            f32x4 a0 = {0.f, 0.f, 0.f, 0.f}, a1 = {0.f, 0.f, 0.f, 0.f};
            if (c4 < 9) {
                const int j = 36 * cb + 4 * c4, kbase = wave * 128 + ks * 32;
#pragma unroll 8
                for (int i = 0; i < 32; ++i) { const int k = kbase + i; const f32x4 wv = *(const f32x4*)(w_ada + (size_t)k * NADA + j);
                    a0 += wv * silu_f(cvec[k]); a1 += wv * silu_f(cvec[DM + k]); }
            }
#pragma unroll
            for (int e = 0; e < 4; ++e) { a0[e] += __shfl_xor(a0[e], 16); a0[e] += __shfl_xor(a0[e], 32); a1[e] += __shfl_xor(a1[e], 16); a1[e] += __shfl_xor(a1[e], 32); }
            __syncthreads();
            if (lane < 9) {
#pragma unroll
                for (int e = 0; e < 4; ++e) { red[(wave * 2 + 0) * 36 + 4 * lane + e] = a0[e]; red[(wave * 2 + 1) * 36 + 4 * lane + e] = a1[e]; }
            }
            __syncthreads();
            if (tid < 72) { const int bb = tid / 36, jj = tid % 36; float s = b_ada[36 * cb + jj];
#pragma unroll
                for (int wv = 0; wv < 8; ++wv) s += red[(wv * 2 + bb) * 36 + jj];
                mod[bb * NADA + 36 * cb + jj] = s; }
        }
        __syncthreads();
    }
    SEAM(0);
    if (IN(0) && IN(1) && G == 256) {
        LAS unsigned* gl = (LAS unsigned*)(lds + 131072 + 512);
        if (tid < 64) { const unsigned a = __hip_atomic_load(xcctab + tid, __ATOMIC_RELAXED, __HIP_MEMORY_SCOPE_AGENT), b2 = __hip_atomic_load(xcctab + tid + 64, __ATOMIC_RELAXED, __HIP_MEMORY_SCOPE_AGENT),
                                           c2 = __hip_atomic_load(xcctab + tid + 128, __ATOMIC_RELAXED, __HIP_MEMORY_SCOPE_AGENT), d2 = __hip_atomic_load(xcctab + tid + 192, __ATOMIC_RELAXED, __HIP_MEMORY_SCOPE_AGENT);
            const bool okg = (a != 0u) && a == b2 && a == c2 && a == d2;
            const unsigned long long m = __ballot(okg);
            if (tid == 0) gl[0] = (m == ~0ull) ? 1u : 0u; }
        __syncthreads();
        grp_local = gl[0] != 0u;
    }
    if (IN(1)) { OPQ(lane);
        for (int m = gw; m < M; m += NGW) { const float* mb = mod + (m >> 13) * NADA; norm_row(x + (size_t)m * DM, XN + (size_t)m * DM, g_ffn1, mb + 0 * DM, mb + 1 * DM, lane); }
        LAS float* scr = (LAS float*)(lds + wave * 16384);
        constexpr int I_1 = (DM / 64) * (NFF / 32);
        for (int it = gw; it < 2 * I_1; it += NGW) { const int bb = it >= I_1 ? 1 : 0; const float* mb = mod + bb * NADA;
            transpose_item_t<true>(w_ffn2_in, DM, NFF, W3 + (size_t)bb * NFF * DM, 1, scr, it - bb * I_1, lane, g_ffn2, mb + 7 * DM, mb + 6 * DM, BIASP + (size_t)bb * 16 * NBIAS + NIN); }
    }
    SEAM(1);
    if (IN(2)) { pg8::Gemm g{XN, W1, M, NFF, DM}; pg8::StaticOrder S; S.init(M, NFF, G, blk); pg8::EpiSwiGLU<false> E{ACT, DFF, nullptr, nullptr};
        pg8::gemm_phase<pg8::EpiSwiGLU<false>, pg8::StaticOrder, true, true>(lds, g, S, E);
        const int hb = (G == 256) ? 128 : 0;
        if (blk >= hb) {
            OPQ(lane);
            LAS float* scr = (LAS float*)(lds + wave * 16384);
            constexpr int I_IN = (DM / 64) * (NIN / 32);
            for (int it = (blk - hb) * 8 + wave; it < 2 * I_IN; it += (G - hb) * 8) { const int bb = it >= I_IN ? 1 : 0; const float* mb = mod + bb * NADA;
                transpose_item_t<true>(w_in, DM, NIN, WIN + (size_t)bb * NIN * DM, 2, scr, it - bb * I_IN, lane, g_mix, mb + 4 * DM, mb + 3 * DM, BIASP + (size_t)bb * 16 * NBIAS); }
        }
    }
    SEAM(2);
    if (IN(3)) {
        for (int idx = blk * 512 + tid; idx < 2 * NBIAS; idx += G * 512) { const int bb = idx / NBIAS, col = idx - bb * NBIAS; float sacc = 0.f;
#pragma unroll
            for (int kb = 0; kb < 16; ++kb) sacc += BIASP[((size_t)bb * 16 + kb) * NBIAS + col];
            BIAS[idx] = sacc; }
        pg8::Gemm g{ACT, W2, M, DM, DFF}; pg8::StaticOrder S; S.init(M, DM, G, blk); pg8::EpiRes2<false, true> E{x, XB1, mod + 2 * DM, 0.5f, ROWP2};
        pg8::gemm_phase<pg8::EpiRes2<false, true>, pg8::StaticOrder, true, true>(lds, g, S, E); }
    SEAM(3);
    if (IN(4)) { pg8::StaticOrder S; S.init(M, NIN, G, blk); pg8::Unit u0; u0.pm = 0; u0.pn = 0; S.next(0, u0); const int bb = u0.pm >> 5;
        LAS float* rsl = (LAS float*)(lds + 131072 + 1024);
        LAS float* bl = (LAS float*)(lds + 131072 + 2048); LAS float* qkg = (LAS float*)(lds + 131072 + 8192);
        if (tid < 256) { rsl[tid] = pg8::rstd_row(ROWP2, u0.pm * 256 + tid); pg8::Unit uu; for (int i = 0; S.next(i, uu); ++i) bl[i * 256 + tid] = BIAS[(size_t)bb * NBIAS + uu.pn * 256 + tid]; }
        else if (tid < 384) qkg[tid - 256] = tid < 320 ? q_gain[tid - 256] : k_gain[tid - 320];
        __syncthreads();
        pg8::Gemm g{XB1, WIN + (size_t)bb * NIN * DM, M, NIN, DM}; pg8::EpiWin E{QB, KB, VB, UB, SG, qkg, rsl, bl};
        pg8::gemm_phase<pg8::EpiWin, pg8::StaticOrder, true, true>(lds, g, S, E); }
    SEAM(4);
    if (IN(5)) {
        OPQ(lane); OPQ(tid);
        for (int u0 = blk; u0 < BATCH * NCHUNK; u0 += G) {
            const int unit = (u0 & 7) * (BATCH * NCHUNK / 8) + (u0 >> 3);
            const int b = unit / NCHUNK, n = unit % NCHUNK;
            attn_wave(lds + wave * 8192, QB, KB, VB, ATT, rel_bias, b, n, wave, lane);
            { const int g = wave >> 1, th = wave & 1;
              if (g == 0) pool_wave<2>(UB, MIX, b, n, 0, th, lane); else if (g == 1) pool_wave<4>(UB, MIX, b, n, 1, th, lane);
              else if (g == 2) pool_wave<8>(UB, MIX, b, n, 2, th, lane); else pool_wave<16>(UB, MIX, b, n, 3, th, lane); }
        }
        __syncthreads();
    }
    SEAM(5);
    if (IN(6)) {
        pg8::Gemm g{ATT, WA, 2 * M, 2 * DM, AW}; pg8::ChainOrder S; S.so.init(M, DM, G, blk); pg8::EpiChain E{TM, (const unsigned char*)SG};
        pg8::gemm_phase<pg8::EpiChain, pg8::ChainOrder, true, true>(lds, g, S, E);
    }
    SEAM_G(6);
    if (IN(7)) { pg8::Gemm g{TM, WO, M, DM, DM}; pg8::StaticOrder S; S.init(M, DM, G, blk); pg8::EpiRes2<true, true> E{XB1, XB2, mod + 5 * DM, 1.0f, ROWP3};
        pg8::gemm_phase<pg8::EpiRes2<true, true>, pg8::StaticOrder, true, true>(lds, g, S, E); }
    SEAM(7);
    if (IN(8)) { pg8::StaticOrder S; S.init(M, NFF, G, blk); pg8::Unit u0; u0.pm = 0; u0.pn = 0; S.next(0, u0); const int bb = u0.pm >> 5;
        LAS float* rsl = (LAS float*)(lds + 131072 + 1024);
        LAS float* bl = (LAS float*)(lds + 131072 + 2048);
        if (tid < 256) { rsl[tid] = pg8::rstd_row(ROWP3, u0.pm * 256 + tid); pg8::Unit uu; for (int i = 0; S.next(i, uu); ++i) bl[i * 256 + tid] = BIAS[(size_t)bb * NBIAS + NIN + uu.pn * 256 + tid]; }
        __syncthreads();
        pg8::Gemm g{XB2, W3 + (size_t)bb * NFF * DM, M, NFF, DM}; pg8::EpiSwiGLU<true> E{ACT2, DFF, rsl, bl};
        pg8::gemm_phase<pg8::EpiSwiGLU<true>, pg8::StaticOrder, true, true>(lds, g, S, E); }
    SEAM_G(8);
    if (IN(9)) { pg8::Gemm g{ACT2, W4, M, DM, DFF}; pg8::StaticOrder S; S.init(M, DM, G, blk); pg8::EpiRes2<true, false> E{XB2, out, mod + 8 * DM, 0.5f, nullptr};
        pg8::gemm_phase<pg8::EpiRes2<true, false>, pg8::StaticOrder, true, true>(lds, g, S, E); }
#undef IN
#undef SEAM
}

extern "C" void kernel_launch(void* const* d_in, const int* in_sizes, int n_in, void* d_out, int out_size, void* d_ws, size_t ws_size, hipStream_t stream) {
    static int grid = 0;
    if (grid == 0) {
        if (n_in != 20 || in_sizes[0] != M * DM || out_size != M * DM || ws_size < WS_END) { fprintf(stderr, "kernel_launch: unexpected shapes (n_in %d, in0 %d, out %d, ws %zu); nothing launched\n", n_in, n_in > 0 ? in_sizes[0] : -1, out_size, ws_size); grid = -1; return; }
        int dev = 0, cus = 0, per_cu = 0;
        if (hipGetDevice(&dev) != hipSuccess || hipDeviceGetAttribute(&cus, hipDeviceAttributeMultiprocessorCount, dev) != hipSuccess) { fprintf(stderr, "kernel_launch: device query failed\n"); grid = -1; return; }
        if (hipFuncSetAttribute((const void*)hybrid_fwd, hipFuncAttributeMaxDynamicSharedMemorySize, LDS_BYTES) != hipSuccess) { fprintf(stderr, "kernel_launch: hipFuncSetAttribute failed\n"); grid = -1; return; }
        if (hipOccupancyMaxActiveBlocksPerMultiprocessor(&per_cu, (const void*)hybrid_fwd, 512, LDS_BYTES) != hipSuccess || per_cu < 1) { fprintf(stderr, "kernel_launch: occupancy query says %d\n", per_cu); per_cu = 1; }
        (void)hipGetLastError();
        grid = cus * per_cu;
        if (grid > 256) grid = 256;
        if (grid != 256) { fprintf(stderr, "kernel_launch: this kernel needs exactly 256 co-resident workgroups (got %d); nothing launched\n", grid); grid = -1; return; }
    }
    if (grid < 0) return;
    if (hipMemsetAsync(d_ws, 0, 65536, stream) != hipSuccess) { fprintf(stderr, "kernel_launch: hipMemsetAsync failed\n"); return; }
    Args a{};
    for (int i = 0; i < 20; ++i) a.in[i] = (const float*)d_in[i];
    a.out = (float*)d_out; a.ws = (unsigned char*)d_ws;
#if MK_PER_PHASE
    for (int k = 0; k < NPHASE; ++k) { a.ph_lo = k; a.ph_hi = k + 1; hipLaunchKernelGGL(hybrid_fwd, dim3(grid), dim3(512), LDS_BYTES, stream, a); }
#else
    a.ph_lo = 0; a.ph_hi = NPHASE;
    void* kargs[] = {&a};
    const hipError_t e = hipLaunchCooperativeKernel((const void*)hybrid_fwd, dim3(grid), dim3(512), kargs, LDS_BYTES, stream);
    if (e != hipSuccess) fprintf(stderr, "kernel_launch: cooperative launch failed: %s (grid %d)\n", hipGetErrorString(e), grid);
#endif
}
```
